# Optimizing an MI355X kernel written in HIP

```python
import math
import jax, jax.numpy as jnp
from jax import lax
import numpy as np

D_MODEL = 1024
BATCH = 2
SEQ = 16384
DEPTH = 1
DEC_BATCH = 16
DEC_SEQ = 16
PAST_LEN = 2048

CHUNK = 64
D_SSM = D_MODEL // 2
SSM_GROUP = 16
N_SSM_GROUPS = D_SSM // SSM_GROUP
SSM_STATE = 64
D_CONV = D_MODEL - D_SSM
CONV_WIDTH = 31
N_MEM = 256
MEM_HEADS = 4
MEM_HEAD_DIM = D_MODEL // MEM_HEADS
D_FF = 4 * D_MODEL
D_IN = D_SSM + 2 * D_CONV
DT_MIN = 1e-3
DT_MAX = 1e-1
LN_EPS = 1e-5
ALPHA = (2.0 * DEPTH) ** 0.25
BETA = (8.0 * DEPTH) ** -0.25

kernel_name = "hybrid_s5_conformer_stream_step"


def layer_norm(x, g, b):
    xf = x.astype(jnp.float32)
    mu = jnp.mean(xf, axis=-1, keepdims=True)
    var = jnp.mean(jnp.square(xf - mu), axis=-1, keepdims=True)
    y = (xf - mu) * lax.rsqrt(var + LN_EPS) * g.astype(jnp.float32) + b.astype(jnp.float32)
    return y.astype(x.dtype)


def s5_discretize(a_re, a_im, log_dt, b_re, b_im):
    f32 = jnp.float32
    a_re = a_re.astype(f32)
    a_im = a_im.astype(f32)
    b_re = b_re.astype(f32)
    b_im = b_im.astype(f32)
    dt = jnp.exp(log_dt.astype(f32))[:, None]
    mag = jnp.exp(a_re * dt)
    ang = a_im * dt
    ab_re = mag * jnp.cos(ang)
    ab_im = mag * jnp.sin(ang)
    den = a_re * a_re + a_im * a_im
    p = ab_re - 1.0
    q = ab_im
    c_re = ((p * a_re + q * a_im) / den)[..., None]
    c_im = ((q * a_re - p * a_im) / den)[..., None]
    bb_re = c_re * b_re - c_im * b_im
    bb_im = c_re * b_im + c_im * b_re
    return ab_re, ab_im, bb_re, bb_im


def s5_block(h0_re, h0_im, u, ab_re, ab_im, bb_re, bb_im, c_re, c_im):
    bu_re = jnp.einsum("gnp,btgp->btgn", bb_re, u)
    bu_im = jnp.einsum("gnp,btgp->btgn", bb_im, u)
    a_re = jnp.broadcast_to(ab_re, bu_re.shape)
    a_im = jnp.broadcast_to(ab_im, bu_im.shape)

    def combine(e1, e2):
        a1r, a1i, b1r, b1i = e1
        a2r, a2i, b2r, b2i = e2
        return (a2r * a1r - a2i * a1i,
                a2r * a1i + a2i * a1r,
                a2r * b1r - a2i * b1i + b2r,
                a2r * b1i + a2i * b1r + b2i)

    pw_re, pw_im, hz_re, hz_im = lax.associative_scan(combine, (a_re, a_im, bu_re, bu_im), axis=1)
    h_re = hz_re + pw_re * h0_re[:, None] - pw_im * h0_im[:, None]
    h_im = hz_im + pw_re * h0_im[:, None] + pw_im * h0_re[:, None]
    y = (jnp.einsum("gpn,btgn->btgp", c_re, h_re)
         - jnp.einsum("gpn,btgn->btgp", c_im, h_im))
    return h_re[:, -1], h_im[:, -1], y


def s5_mixer(u, h0_re, h0_im, lw):
    f32 = jnp.float32
    bsz, t_len, _ = u.shape
    uf = u.astype(f32).reshape(bsz, t_len, N_SSM_GROUPS, SSM_GROUP)
    ab_re, ab_im, bb_re, bb_im = s5_discretize(lw["ssm_a_re"], lw["ssm_a_im"], lw["ssm_log_dt"],
                                               lw["ssm_b_re"], lw["ssm_b_im"])
    c_re = lw["ssm_c_re"].astype(f32)
    c_im = lw["ssm_c_im"].astype(f32)
    h0_re = h0_re.astype(f32)
    h0_im = h0_im.astype(f32)
    if t_len > CHUNK:
        n_blk = t_len // CHUNK
        ub = uf.reshape(bsz, n_blk, CHUNK, N_SSM_GROUPS, SSM_GROUP).transpose(1, 0, 2, 3, 4)

        def step(carry, u_blk):
            hr, hi = carry
            hr, hi, y_blk = s5_block(hr, hi, u_blk, ab_re, ab_im, bb_re, bb_im, c_re, c_im)
            return (hr, hi), y_blk

        (h_re, h_im), ys = lax.scan(step, (h0_re, h0_im), ub)
        y = ys.transpose(1, 0, 2, 3, 4).reshape(bsz, t_len, D_SSM)
    else:
        h_re, h_im, y = s5_block(h0_re, h0_im, uf, ab_re, ab_im, bb_re, bb_im, c_re, c_im)
        y = y.reshape(bsz, t_len, D_SSM)
    z = jax.nn.gelu(y + lw["ssm_d"].astype(f32) * u.astype(f32))
    out = z * jax.nn.sigmoid(z @ lw["glu_w"].astype(f32) + lw["glu_b"].astype(f32))
    return out.astype(u.dtype), h_re, h_im


def conv_mixer(pa, pg, conv_buf, lw):
    v = pa * jax.nn.sigmoid(pg)
    vp = jnp.concatenate([conv_buf.astype(v.dtype), v], axis=1)
    h = lax.conv_general_dilated(vp, lw["conv_w"][:, None, :].astype(v.dtype),
                                 window_strides=(1,), padding="VALID",
                                 dimension_numbers=("NWC", "WIO", "NWC"),
                                 feature_group_count=D_CONV)
    h = h + lw["conv_b"].astype(v.dtype)
    h = jax.nn.swish(layer_norm(h, lw["conv_ln_g"], lw["conv_ln_b"]))
    return h, vp[:, -(CONV_WIDTH - 1):]


def memory_kv(mem, w_k, w_v):
    bsz = mem.shape[0]
    k = (mem @ w_k).reshape(bsz, N_MEM, MEM_HEADS, MEM_HEAD_DIM)
    v = (mem @ w_v).reshape(bsz, N_MEM, MEM_HEADS, MEM_HEAD_DIM)
    return k, v


def memory_attend(x, mem_k, mem_v, w_q, w_o):
    bsz, t_len, _ = x.shape
    q = (x @ w_q).reshape(bsz, t_len, MEM_HEADS, MEM_HEAD_DIM)
    s = jnp.einsum("bthd,bmhd->bhtm", q, mem_k.astype(q.dtype),
                   preferred_element_type=jnp.float32) * (MEM_HEAD_DIM ** -0.5)
    p = jax.nn.softmax(s, axis=-1).astype(x.dtype)
    o = jnp.einsum("bhtm,bmhd->bthd", p, mem_v.astype(x.dtype)).reshape(bsz, t_len, D_MODEL)
    return o @ w_o


def encoder_layer(x, h0_re, h0_im, conv_buf, mem_k, mem_v, lw):
    proj = x @ lw["w_in"]
    u = proj[..., :D_SSM]
    pa = proj[..., D_SSM:D_SSM + D_CONV]
    pg = proj[..., D_SSM + D_CONV:]
    ya, h_re, h_im = s5_mixer(u, h0_re, h0_im, lw)
    yb, new_conv = conv_mixer(pa, pg, conv_buf, lw)
    mix = jnp.concatenate([ya, yb.astype(ya.dtype)], axis=-1) @ lw["w_out"]
    x = layer_norm(ALPHA * x + mix, lw["ln1_g"], lw["ln1_b"])
    att = memory_attend(x, mem_k, mem_v, lw["mem_w_q"], lw["mem_w_o"])
    x = layer_norm(ALPHA * x + att, lw["ln2_g"], lw["ln2_b"])
    hid = jnp.square(jax.nn.relu(x @ lw["mlp_w1"] + lw["mlp_b1"]))
    x = layer_norm(ALPHA * x + hid @ lw["mlp_w2"] + lw["mlp_b2"], lw["ln3_g"], lw["ln3_b"])
    return x, h_re, h_im, new_conv


def setup_inputs(seed: int = 0) -> dict:
    key = jax.random.key(seed)
    ks = jax.random.split(key, 40)
    f32 = jnp.float32
    nrm = lambda k, shape, s: (jax.random.normal(k, shape, f32) * s)
    L = DEPTH
    n_idx = jnp.arange(SSM_STATE, dtype=f32)
    inp = {}
    inp["x_prompt"] = nrm(ks[0], (BATCH, SEQ, D_MODEL), 1.0)
    inp["x_sample"] = nrm(ks[1], (DEC_BATCH, DEC_SEQ, D_MODEL), 1.0)
    inp["state_ssm_re"] = nrm(ks[2], (L, DEC_BATCH, N_SSM_GROUPS, SSM_STATE), 0.5)
    inp["state_ssm_im"] = nrm(ks[3], (L, DEC_BATCH, N_SSM_GROUPS, SSM_STATE), 0.5)
    inp["cache_conv"] = nrm(ks[4], (L, DEC_BATCH, CONV_WIDTH - 1, D_CONV), 1.0)
    inp["cache_mem_k"] = nrm(ks[5], (L, DEC_BATCH, N_MEM, MEM_HEADS, MEM_HEAD_DIM), 1.0)
    inp["cache_mem_v"] = nrm(ks[6], (L, DEC_BATCH, N_MEM, MEM_HEADS, MEM_HEAD_DIM), BETA)
    inp["mem_prompt"] = nrm(ks[7], (BATCH, N_MEM, D_MODEL), 1.0)
    inp["w_in"] = nrm(ks[8], (L, D_MODEL, D_IN), D_MODEL ** -0.5)
    inp["ssm_a_re"] = -0.5 + nrm(ks[9], (L, N_SSM_GROUPS, SSM_STATE), 0.01)
    inp["ssm_a_im"] = math.pi * n_idx + nrm(ks[10], (L, N_SSM_GROUPS, SSM_STATE), 0.01)
    inp["ssm_log_dt"] = jax.random.uniform(ks[11], (L, N_SSM_GROUPS), f32,
                                           minval=math.log(DT_MIN), maxval=math.log(DT_MAX))
    inp["ssm_b_re"] = nrm(ks[12], (L, N_SSM_GROUPS, SSM_STATE, SSM_GROUP), (2 * SSM_GROUP) ** -0.5)
    inp["ssm_b_im"] = nrm(ks[13], (L, N_SSM_GROUPS, SSM_STATE, SSM_GROUP), (2 * SSM_GROUP) ** -0.5)
    inp["ssm_c_re"] = nrm(ks[14], (L, N_SSM_GROUPS, SSM_GROUP, SSM_STATE), SSM_STATE ** -0.5)
    inp["ssm_c_im"] = nrm(ks[15], (L, N_SSM_GROUPS, SSM_GROUP, SSM_STATE), SSM_STATE ** -0.5)
    inp["ssm_d"] = nrm(ks[16], (L, D_SSM), 1.0)
    inp["glu_w"] = nrm(ks[17], (L, D_SSM, D_SSM), D_SSM ** -0.5)
    inp["glu_b"] = nrm(ks[18], (L, D_SSM), 0.01)
    inp["conv_w"] = nrm(ks[19], (L, CONV_WIDTH, D_CONV), CONV_WIDTH ** -0.5)
    inp["conv_b"] = nrm(ks[20], (L, D_CONV), 0.01)
    inp["conv_ln_g"] = 1.0 + nrm(ks[21], (L, D_CONV), 0.02)
    inp["conv_ln_b"] = nrm(ks[22], (L, D_CONV), 0.02)
    inp["w_out"] = nrm(ks[23], (L, D_MODEL, D_MODEL), BETA * D_MODEL ** -0.5)
    inp["ln1_g"] = 1.0 + nrm(ks[24], (L, D_MODEL), 0.02)
    inp["ln1_b"] = nrm(ks[25], (L, D_MODEL), 0.02)
    inp["mem_w_q"] = nrm(ks[26], (L, D_MODEL, D_MODEL), D_MODEL ** -0.5)
    inp["mem_w_k"] = nrm(ks[27], (L, D_MODEL, D_MODEL), D_MODEL ** -0.5)
    inp["mem_w_v"] = nrm(ks[28], (L, D_MODEL, D_MODEL), BETA * D_MODEL ** -0.5)
    inp["mem_w_o"] = nrm(ks[29], (L, D_MODEL, D_MODEL), BETA * D_MODEL ** -0.5)
    inp["ln2_g"] = 1.0 + nrm(ks[30], (L, D_MODEL), 0.02)
    inp["ln2_b"] = nrm(ks[31], (L, D_MODEL), 0.02)
    inp["mlp_w1"] = nrm(ks[32], (L, D_MODEL, D_FF), BETA * D_MODEL ** -0.5)
    inp["mlp_b1"] = nrm(ks[33], (L, D_FF), 0.01)
    inp["mlp_w2"] = nrm(ks[34], (L, D_FF, D_MODEL), BETA * D_FF ** -0.5)
    inp["mlp_b2"] = nrm(ks[35], (L, D_MODEL), 0.01)
    inp["ln3_g"] = 1.0 + nrm(ks[36], (L, D_MODEL), 0.02)
    inp["ln3_b"] = nrm(ks[37], (L, D_MODEL), 0.02)
    return inp


def reference(x_prompt, x_sample, state_ssm_re, state_ssm_im, cache_conv, cache_mem_k, cache_mem_v,
              mem_prompt, w_in, ssm_a_re, ssm_a_im, ssm_log_dt, ssm_b_re, ssm_b_im, ssm_c_re, ssm_c_im,
              ssm_d, glu_w, glu_b, conv_w, conv_b, conv_ln_g, conv_ln_b, w_out, ln1_g, ln1_b,
              mem_w_q, mem_w_k, mem_w_v, mem_w_o, ln2_g, ln2_b,
              mlp_w1, mlp_b1, mlp_w2, mlp_b2, ln3_g, ln3_b):
    yp = x_prompt
    ys = x_sample
    p_re, p_im, p_conv, p_mk, p_mv = [], [], [], [], []
    s_re, s_im, s_conv = [], [], []
    zero_h = jnp.zeros((x_prompt.shape[0], N_SSM_GROUPS, SSM_STATE), jnp.float32)
    zero_conv = jnp.zeros((x_prompt.shape[0], CONV_WIDTH - 1, D_CONV), x_prompt.dtype)
    for l in range(DEPTH):
        lw = dict(w_in=w_in[l], ssm_a_re=ssm_a_re[l], ssm_a_im=ssm_a_im[l], ssm_log_dt=ssm_log_dt[l],
                  ssm_b_re=ssm_b_re[l], ssm_b_im=ssm_b_im[l], ssm_c_re=ssm_c_re[l], ssm_c_im=ssm_c_im[l],
                  ssm_d=ssm_d[l], glu_w=glu_w[l], glu_b=glu_b[l], conv_w=conv_w[l], conv_b=conv_b[l],
                  conv_ln_g=conv_ln_g[l], conv_ln_b=conv_ln_b[l], w_out=w_out[l],
                  ln1_g=ln1_g[l], ln1_b=ln1_b[l], mem_w_q=mem_w_q[l], mem_w_o=mem_w_o[l],
                  ln2_g=ln2_g[l], ln2_b=ln2_b[l], mlp_w1=mlp_w1[l], mlp_b1=mlp_b1[l],
                  mlp_w2=mlp_w2[l], mlp_b2=mlp_b2[l], ln3_g=ln3_g[l], ln3_b=ln3_b[l])
        mk, mv = memory_kv(mem_prompt, mem_w_k[l], mem_w_v[l])
        yp, hr, hi, cb = encoder_layer(yp, zero_h, zero_h, zero_conv, mk, mv, lw)
        p_re.append(hr)
        p_im.append(hi)
        p_conv.append(cb)
        p_mk.append(mk)
        p_mv.append(mv)
        ys, hr, hi, cb = encoder_layer(ys, state_ssm_re[l], state_ssm_im[l], cache_conv[l],
                                       cache_mem_k[l], cache_mem_v[l], lw)
        s_re.append(hr)
        s_im.append(hi)
        s_conv.append(cb)
    return (yp, ys, jnp.stack(p_re), jnp.stack(p_im), jnp.stack(p_conv), jnp.stack(p_mk),
            jnp.stack(p_mv), jnp.stack(s_re), jnp.stack(s_im), jnp.stack(s_conv))
```

```cpp
#include <hip/hip_runtime.h>
#include <hip/hip_cooperative_groups.h>
#include <cstdio>
#include <cstdint>
namespace cg = cooperative_groups;

#define LAS __attribute__((address_space(3)))
typedef unsigned short bf16_t;
typedef short bf16x8 __attribute__((ext_vector_type(8)));
typedef float f32x4 __attribute__((ext_vector_type(4)));
typedef float f32x2 __attribute__((ext_vector_type(2)));
typedef unsigned u32x4 __attribute__((ext_vector_type(4)));
typedef unsigned u32x2 __attribute__((ext_vector_type(2)));
typedef __bf16 bf16v2 __attribute__((ext_vector_type(2)));

constexpr int DM = 1024, SEQ = 16384, NB = 2, NP = NB * SEQ, NSB = 16, NST = 16, NS = NSB * NST, R = NP + NS, RPAD = R + 256;
constexpr int DSSM = 512, DCONV = 512, DIN = 1536, DFF = 4096, NMEM = 256, NH = 4, HD = 256, NG = 32, NSTATE = 64, CW = 31;
constexpr float ALPHA = 1.189207115002721f;
constexpr float LN_EPS = 1e-5f;
constexpr size_t O_Y = 0, O_SRP = (size_t)R * DM, O_SIP = O_SRP + 4096, O_CVP = O_SIP + 4096, O_MKP = O_CVP + 30720, O_MVP = O_MKP + 524288,
                 O_SRS = O_MVP + 524288, O_SIS = O_SRS + 32768, O_CVS = O_SIS + 32768;
constexpr size_t MiB = 1u << 20;
constexpr size_t WS_WIN = 1 * MiB, WS_GLU = 4 * MiB, WS_WOUT = 5 * MiB, WS_WQ = 7 * MiB, WS_WKV = 9 * MiB, WS_WO = 13 * MiB, WS_W1 = 15 * MiB, WS_W2 = 23 * MiB,
                 WS_SSMW = 460 * MiB  , WS_M1 = 33 * MiB  , WS_WST = 34 * MiB  , WS_MEMB = 35 * MiB  ,
                 WS_KB = 36 * MiB  , WS_VT = 45 * MiB  ;
constexpr size_t WS_S1 = 56 * MiB, WS_S2 = 122 * MiB, WS_BIG = 188 * MiB;
constexpr size_t WS_T1 = WS_S1, WS_T2 = WS_S2;
constexpr size_t WS_CSP = 54 * MiB  , WS_CSF = 55 * MiB  ;
constexpr size_t WS_ST1 = 448 * MiB, WS_ST2 = 453 * MiB;
constexpr size_t WS_XB = WS_BIG, WS_UB = WS_BIG + 66 * MiB, WS_VB = WS_BIG + 99 * MiB, WS_ZB = WS_BIG + 132 * MiB, WS_CAT = WS_BIG + 165 * MiB;
constexpr size_t WS_QB = WS_BIG, WS_PB = WS_BIG + 66 * MiB, WS_OB = WS_BIG + 132 * MiB, WS_HB = WS_BIG;
constexpr size_t WS_V16 = 464 * MiB  , WS_NT = 465 * MiB  ;
constexpr size_t WS_END = 470 * MiB;
constexpr int SSM_NFRAG = 96, SSM_FRAG_ELEMS = SSM_NFRAG * 512;
constexpr int SSM_M1_OFF = SSM_FRAG_ELEMS * 2;

#ifndef PROBE_DUP
#define PROBE_DUP 0
#endif
#ifndef PHASE_MASK
#define PHASE_MASK 0xFFFF
#endif
constexpr int LDS_BYTES = 147456;
constexpr int RING_BYTES = 131072;

struct Params {
    const float* in[38];
    float* out;
    unsigned char* ws;
};

__device__ __forceinline__ unsigned cvt_pk_bf16(float lo, float hi) { unsigned r; asm("v_cvt_pk_bf16_f32 %0, %1, %2" : "=v"(r) : "v"(lo), "v"(hi)); return r; }
__device__ __forceinline__ float bf_lo(unsigned w) { return __uint_as_float(w << 16); }
__device__ __forceinline__ float bf_hi(unsigned w) { return __uint_as_float(w & 0xffff0000u); }
__device__ __forceinline__ unsigned short f2bf(float f) { return (unsigned short)(cvt_pk_bf16(f, 0.f) & 0xffffu); }
__device__ __forceinline__ float sigmoidf_(float x) { return __builtin_amdgcn_rcpf(1.f + __builtin_amdgcn_exp2f(-1.4426950408889634f * x)); }
__device__ __forceinline__ float gelu_tanh(float x) {
    const float t = x * x, u = x * (-2.3022082f - 0.10294324f * t); return x * __builtin_amdgcn_rcpf(1.f + __builtin_amdgcn_exp2f(u)); }
template <int CTRL> __device__ __forceinline__ float dppf(float v) {
    return __builtin_bit_cast(float, __builtin_amdgcn_update_dpp(0, __builtin_bit_cast(int, v), CTRL, 0xf, 0xf, true));
}
#define DPP_SHR(n) (0x110 + (n))
#define DPP_ROR(n) (0x120 + (n))
#define LDS_BARRIER() do { asm volatile("s_waitcnt lgkmcnt(0)" ::: "memory"); __builtin_amdgcn_s_barrier(); asm volatile("" ::: "memory"); } while (0)
__device__ __forceinline__ float wave_sum(float v) {
#pragma unroll
    for (int o = 1; o < 64; o <<= 1) v += __shfl_xor(v, o);
    return v;
}

namespace pg8 {
constexpr int BM = 256, BK = 64, HALF = 128, HTB = HALF * BK * 2, STAGE_BYTES = 8 * HTB;
__host__ __device__ __forceinline__ int lds_byte(int r, int c) { const int st = (r >> 4) * 2 + (c >> 5), rr = r & 15, cc = c & 31, ob = rr * 64 + cc * 2; return st * 1024 + (ob ^ (((ob >> 9) & 1) << 5)); }
__host__ __device__ __forceinline__ void stage_rc(int b, int& Rr, int& C) { const int st = b / 1024, sb = b % 1024, swz = sb ^ (((sb >> 9) & 1) << 5); Rr = (st >> 1) * 16 + swz / 64; C = (st & 1) * 32 + (swz % 64) / 2; }
__host__ __device__ __forceinline__ int perm32(int rho) { const int n = rho >> 4, i = rho & 15; return 8 * (i >> 2) + 4 * n + (i & 3); }

struct Unit { int row0, col0, nvalid, aux; };
struct GemmDesc { int K, lda, ldb; };

template <class Epi, class Sched, bool ALIGN_EPI>
__device__ __forceinline__ void gemm_phase(LAS unsigned char* lds, const GemmDesc g, const Sched& S, const Epi& E) {
    int tid = threadIdx.x; asm volatile("" : "+v"(tid));
    const int wid = __builtin_amdgcn_readfirstlane(tid >> 6), lane = tid & 63, wr = wid >> 2, wc = wid & 3, fr = lane & 15, fq = lane >> 4;
    const int K = g.K, nt = K / BK;
    unsigned voffA[2], voffB[2];
#pragma unroll
    for (int i = 0; i < 2; ++i) { int Rr, C; stage_rc(tid * 16 + i * 8192, Rr, C); const int Rb = Epi::PERM ? ((Rr & ~31) + perm32(Rr & 31)) : Rr;
        voffA[i] = (unsigned)(Rr * g.lda + C) * 2u; voffB[i] = (unsigned)(Rb * g.ldb + C) * 2u; }
    const size_t kstep = (size_t)(BK * 2);
    const size_t hstepA = (size_t)HALF * g.lda * 2, hstepB = (size_t)HALF * g.ldb * 2;
    const unsigned ldsw = (unsigned)wid * 1024u;
    const int aoff = lds_byte(wr * 64 + fr, fq * 8), boff = lds_byte(wc * 32 + fr, fq * 8);
#define PG8_SA(b, h) (((b) * 2 + (h)) * HTB)
#define PG8_SB(b, h) ((4 + (b) * 2 + (h)) * HTB)
#define PG8_STAGE(bufoff, gbase, voff) do { _Pragma("unroll") for (int _i = 0; _i < 2; ++_i) \
        __builtin_amdgcn_global_load_lds((const unsigned*)((const char*)(gbase) + (voff)[_i]), (LAS unsigned*)(lds + (bufoff) + ldsw + _i * 8192), 16, 0, 0); } while (0)
#define PG8_LDA(dst, b, h) do { _Pragma("unroll") for (int m = 0; m < 4; ++m) _Pragma("unroll") for (int k = 0; k < 2; ++k) dst[m][k] = *(const LAS bf16x8*)(lds + PG8_SA(b, h) + aoff + m * 2048 + k * 1024); } while (0)
#define PG8_LDB(dst, b, h) do { _Pragma("unroll") for (int n = 0; n < 2; ++n) _Pragma("unroll") for (int k = 0; k < 2; ++k) dst[n][k] = *(const LAS bf16x8*)(lds + PG8_SB(b, h) + boff + n * 2048 + k * 1024); } while (0)
#define PG8_MMA(ai, bj, At, Bt) do { __builtin_amdgcn_s_setprio(1); _Pragma("unroll") for (int m = 0; m < 4; ++m) _Pragma("unroll") for (int n = 0; n < 2; ++n) _Pragma("unroll") for (int k = 0; k < 2; ++k) \
        acc[ai][bj][m][n] = __builtin_amdgcn_mfma_f32_16x16x32_bf16(Bt[n][k], At[m][k], acc[ai][bj][m][n], 0, 0, 0); __builtin_amdgcn_s_setprio(0); } while (0)
#define PG8_WAIT_V(n) asm volatile("s_waitcnt vmcnt(" #n ")" ::: "memory")
#define PG8_WAIT_L(n) asm volatile("s_waitcnt lgkmcnt(" #n ")" ::: "memory")
#define PG8_BAR __builtin_amdgcn_s_barrier()
#define PG8_SCHED __builtin_amdgcn_sched_barrier(0)
    Unit cur, nxt; int ui = 0;
    if (!S.next(0, cur)) return;
    f32x4 acc[2][2][4][2];
#pragma unroll
    for (int a = 0; a < 2; ++a)
#pragma unroll
        for (int b = 0; b < 2; ++b)
#pragma unroll
            for (int m = 0; m < 4; ++m)
#pragma unroll
                for (int n = 0; n < 2; ++n) acc[a][b][m][n] = (f32x4){0.f, 0.f, 0.f, 0.f};
    bf16x8 At[4][2], B0[2][2], B1[2][2];
    const char* cA = S.aptr(cur); const char* cB = S.bptr(cur);
    PG8_STAGE(PG8_SB(0, 0), cB, voffB); PG8_STAGE(PG8_SB(0, 1), cB + hstepB, voffB); PG8_STAGE(PG8_SA(0, 0), cA, voffA); PG8_STAGE(PG8_SA(0, 1), cA + hstepA, voffA);
    if (wr == 1) PG8_BAR;
    PG8_WAIT_V(2); PG8_BAR;
    PG8_STAGE(PG8_SB(1, 0), cB + kstep, voffB); PG8_STAGE(PG8_SA(1, 0), cA + kstep, voffA); PG8_STAGE(PG8_SB(1, 1), cB + hstepB + kstep, voffB);
    PG8_WAIT_V(6); PG8_BAR;
    for (;;) {
        const bool has_next = S.next(ui + 1, nxt);
        const char* nA = has_next ? S.aptr(nxt) : cA; const char* nB = has_next ? S.bptr(nxt) : cB;
        for (int t = 0; t < nt; t += 2) {
            const bool last = (t == nt - 2);
            const char* a1 = cA + (size_t)(t + 1) * kstep;
            const char* a2 = last ? nA : cA + (size_t)(t + 2) * kstep; const char* b2 = last ? nB : cB + (size_t)(t + 2) * kstep;
            const char* a3 = a2 + kstep; const char* b3 = b2 + kstep;
            PG8_LDB(B0, 0, 0); PG8_LDB(B1, 0, 1); PG8_SCHED; PG8_LDA(At, 0, 0); PG8_STAGE(PG8_SA(1, 1), a1 + hstepA, voffA);
            PG8_WAIT_V(8); PG8_WAIT_L(0); PG8_BAR; PG8_MMA(0, 0, At, B0); PG8_MMA(0, 1, At, B1); PG8_BAR; PG8_SCHED;
            PG8_LDA(At, 0, 1); PG8_STAGE(PG8_SB(0, 0), b2, voffB); PG8_STAGE(PG8_SB(0, 1), b2 + hstepB, voffB); PG8_STAGE(PG8_SA(0, 0), a2, voffA);
            PG8_WAIT_V(8); PG8_WAIT_L(0); PG8_BAR; PG8_MMA(1, 0, At, B0); PG8_MMA(1, 1, At, B1); PG8_BAR; PG8_SCHED;
            PG8_LDB(B0, 1, 0); PG8_LDB(B1, 1, 1); PG8_SCHED; PG8_LDA(At, 1, 0); PG8_STAGE(PG8_SA(0, 1), a2 + hstepA, voffA);
            PG8_WAIT_V(8); PG8_WAIT_L(0); PG8_BAR; PG8_MMA(0, 0, At, B0); PG8_MMA(0, 1, At, B1); PG8_BAR; PG8_SCHED;
            PG8_LDA(At, 1, 1); PG8_STAGE(PG8_SB(1, 0), b3, voffB); PG8_STAGE(PG8_SB(1, 1), b3 + hstepB, voffB); PG8_STAGE(PG8_SA(1, 0), a3, voffA);
            PG8_WAIT_V(8); PG8_WAIT_L(0); PG8_BAR; PG8_MMA(1, 0, At, B0); PG8_MMA(1, 1, At, B1); PG8_BAR; PG8_SCHED;
        }
        if constexpr (ALIGN_EPI) { if (wr == 0) PG8_BAR; }
        E(acc, cur, wr, wc, fr, fq, lds + STAGE_BYTES);
        if (!has_next) break;
#pragma unroll
        for (int a = 0; a < 2; ++a)
#pragma unroll
            for (int b = 0; b < 2; ++b)
#pragma unroll
                for (int m = 0; m < 4; ++m)
#pragma unroll
                    for (int n = 0; n < 2; ++n) acc[a][b][m][n] = (f32x4){0.f, 0.f, 0.f, 0.f};
        cur = nxt; cA = nA; cB = nB; ++ui;
        if constexpr (ALIGN_EPI) { if (wr == 1) PG8_BAR; }
    }
    PG8_WAIT_V(0);
    if constexpr (!ALIGN_EPI) { if (wr == 0) PG8_BAR; }
    PG8_BAR;
#undef PG8_SA
#undef PG8_SB
#undef PG8_STAGE
#undef PG8_LDA
#undef PG8_LDB
#undef PG8_MMA
#undef PG8_WAIT_V
#undef PG8_WAIT_L
#undef PG8_BAR
#undef PG8_SCHED
}

struct RegSched {
    const bf16_t* A; const bf16_t* B; int lda, ldb, nM, nN, nwg, G, c;
    __device__ void init(const bf16_t* A_, int lda_, const bf16_t* B_, int ldb_, int M, int N, int G_, int c_) { A = A_; B = B_; lda = lda_; ldb = ldb_; nM = M / BM; nN = N / BM; nwg = nM * nN; G = G_; c = c_; }
    __device__ bool next(int i, Unit& u) const {
        const long L = (long)i * G + c; if (L >= nwg) return false;
        int wgid = (int)L; { const int q = nwg / 8, r = nwg % 8, xcd = wgid % 8, off = wgid / 8; wgid = (xcd < r ? xcd * (q + 1) : r * (q + 1) + (xcd - r) * q) + off; }
        const int nig = 8 * nN, gid = wgid / nig, fm = gid * 8, gsz = (nM - fm) < 8 ? (nM - fm) : 8;
        const int pm = fm + ((wgid % nig) % gsz), pn = (wgid % nig) / gsz;
        u.row0 = pm * BM; u.col0 = pn * BM; u.nvalid = BM; u.aux = pn; return true;
    }
    __device__ const char* aptr(const Unit& u) const { return (const char*)(A + (size_t)u.row0 * lda); }
    __device__ const char* bptr(const Unit& u) const { return (const char*)(B + (size_t)u.col0 * ldb); }
};
struct BatchSched : RegSched {
    __device__ const char* bptr(const Unit& u) const { return (const char*)(B + (u.row0 >= SEQ ? (size_t)DM * DM : 0) + (size_t)u.col0 * ldb); }
};
struct AttSched {
    const bf16_t* A; const bf16_t* B; int pv, G, c, skip;
    __device__ bool next(int i, Unit& u) const {
        int L;
        if (skip) L = i * G + c + skip;
        else if (G == 256) { if (c < 64) L = (i == 0) ? c : (i == 1 ? 512 + c : 1 << 20); else L = c + 192 * i; if (c >= 64 && L >= 512) L = 1 << 20; }
        else L = i * G + c;
        if (L >= 512 + 64) return false;
        if (L < 512) { const int pm = L >> 2, h = L & 3; u.row0 = pm * 256; u.col0 = h * 256; u.nvalid = 256; u.aux = pm >> 6; }
        else { const int idx = L - 512, js = idx >> 2, h = idx & 3; u.row0 = NP + NST * js + NST - 256; u.col0 = h * 256; u.nvalid = -NST; u.aux = 2 + js; }
        return true;
    }
    __device__ const char* aptr(const Unit& u) const { return (const char*)(A + (size_t)u.row0 * DM + u.col0); }
    __device__ const char* bptr(const Unit& u) const {
        return (const char*)(pv ? B + (size_t)u.aux * (DM * NMEM) + (size_t)u.col0 * NMEM : B + (size_t)u.aux * (NMEM * DM) + u.col0); }
};

#define EPI_FOR_ROWS for (int ai = 0; ai < 2; ++ai) _Pragma("unroll") for (int m = 0; m < 4; ++m)
__device__ __forceinline__ u32x4 pack8(const f32x4 a, const f32x4 b) { u32x4 w; w.x = cvt_pk_bf16(a[0], a[1]); w.y = cvt_pk_bf16(a[2], a[3]); w.z = cvt_pk_bf16(b[0], b[1]); w.w = cvt_pk_bf16(b[2], b[3]); return w; }
__device__ __forceinline__ void unpack8(const u32x4 w, f32x4& a, f32x4& b) { a = (f32x4){bf_lo(w.x), bf_hi(w.x), bf_lo(w.y), bf_hi(w.y)}; b = (f32x4){bf_lo(w.z), bf_hi(w.z), bf_lo(w.w), bf_hi(w.w)}; }

template <int MODE> struct EpiGen {
    static constexpr bool PERM = true;
    void* O; int ldo; const bf16_t* res; int ldr; const float* bias; float scale;
    __device__ __forceinline__ void piece(size_t row, int col, f32x4 v0, f32x4 v1, const f32x4 b0, const f32x4 b1) const {
        if constexpr (MODE == 0) { v0 = v0 * scale; v1 = v1 * scale; *(u32x4*)((bf16_t*)O + row * ldo + col) = pack8(v0, v1); }
        if constexpr (MODE == 1) { f32x4 r0, r1; unpack8(*(const u32x4*)(res + row * ldr + col), r0, r1); v0 = r0 * ALPHA + v0; v1 = r1 * ALPHA + v1; *(u32x4*)((bf16_t*)O + row * ldo + col) = pack8(v0, v1); }
        if constexpr (MODE == 2) { v0 = v0 + b0; v1 = v1 + b1;
#pragma unroll
            for (int e = 0; e < 4; ++e) { const float a = fmaxf(v0[e], 0.f), b = fmaxf(v1[e], 0.f); v0[e] = a * a; v1[e] = b * b; }
            *(u32x4*)((bf16_t*)O + row * ldo + col) = pack8(v0, v1); }
        if constexpr (MODE == 3) { f32x4 r0, r1; unpack8(*(const u32x4*)(res + row * ldr + col), r0, r1); v0 = r0 * ALPHA + v0 + b0; v1 = r1 * ALPHA + v1 + b1;
            float* o = (float*)O + row * ldo + col; *(f32x4*)o = v0; *(f32x4*)(o + 4) = v1; }
        if constexpr (MODE == 4) { f32x4 r0, r1; unpack8(*(const u32x4*)(res + row * ldr + col), r0, r1); v0 = v0 + b0; v1 = v1 + b1;
#pragma unroll
            for (int e = 0; e < 4; ++e) { v0[e] = r0[e] * sigmoidf_(v0[e]); v1[e] = r1[e] * sigmoidf_(v1[e]); }
            *(u32x4*)((bf16_t*)O + row * ldo + col) = pack8(v0, v1); }
    }
    __device__ __forceinline__ void small(size_t row, int col, const f32x4 v0, const f32x4 v1) const {
        const f32x4 z = (f32x4){0.f, 0.f, 0.f, 0.f};
        piece(row, col, v0, v1, (MODE >= 2) ? *(const f32x4*)(bias + col) : z, (MODE >= 2) ? *(const f32x4*)(bias + col + 4) : z);
    }
    __device__ __forceinline__ void operator()(const f32x4 (&acc)[2][2][4][2], const Unit& u, int wr, int wc, int fr_, int fq_, LAS unsigned char*) const {
        int fr = fr_, fq = fq_; asm volatile("" : "+v"(fr), "+v"(fq));
        const int colb = u.col0 + wc * 32 + 8 * fq;
        f32x4 bv[2][2];
#pragma unroll
        for (int bj = 0; bj < 2; ++bj)
#pragma unroll
            for (int n = 0; n < 2; ++n) bv[bj][n] = (MODE >= 2) ? *(const f32x4*)(bias + colb + bj * HALF + 4 * n) : (f32x4){0.f, 0.f, 0.f, 0.f};
#pragma unroll
        EPI_FOR_ROWS {
            const int rl = ai * HALF + wr * 64 + m * 16 + fr; const size_t row = (size_t)u.row0 + rl;
            if (MODE == 0 && !(u.nvalid >= 0 ? rl < u.nvalid : rl >= 256 + u.nvalid)) continue;
#pragma unroll
            for (int bj = 0; bj < 2; ++bj) piece(row, colb + bj * HALF, acc[ai][bj][m][0], acc[ai][bj][m][1], bv[bj][0], bv[bj][1]);
        }
    }
};

template <int MODE> struct EpiLn {
    static constexpr bool PERM = true, CONS = (MODE != 1), PROD = (MODE == 1 || MODE == 3), RECOMP = (MODE == 3 || MODE == 5);
    void* O; int ldo; const bf16_t* Tin; const f32x2* st_in; f32x2* st_out; const float* va; const float* vb; const float* bias; float scale; int tag0;
    __device__ __forceinline__ void piece(size_t row, int col, f32x4 v0, f32x4 v1, const f32x4 a0, const f32x4 a1, const f32x4 b0, const f32x4 b1, const f32x4 c0, const f32x4 c1,
                                          float mean, float rstd, float& s, float& ss) const {
        if constexpr (MODE == 1) { f32x4 r0, r1; unpack8(*(const u32x4*)(Tin + row * DM + col), r0, r1); v0 = r0 * ALPHA + v0; v1 = r1 * ALPHA + v1; }
        if constexpr (MODE == 2) { v0 = ((v0 - a0 * mean) * rstd + b0) * scale; v1 = ((v1 - a1 * mean) * rstd + b1) * scale; }
        if constexpr (RECOMP) { f32x4 r0, r1; unpack8(*(const u32x4*)(Tin + row * DM + col), r0, r1);
            r0 = (r0 - mean) * rstd * a0 + b0; r1 = (r1 - mean) * rstd * a1 + b1; v0 = r0 * ALPHA + v0; v1 = r1 * ALPHA + v1;
            if constexpr (MODE == 5) { v0 = v0 + c0; v1 = v1 + c1; } }
        if constexpr (MODE == 4) { v0 = (v0 - a0 * mean) * rstd + b0; v1 = (v1 - a1 * mean) * rstd + b1;
#pragma unroll
            for (int e = 0; e < 4; ++e) { const float x = fmaxf(v0[e], 0.f), y = fmaxf(v1[e], 0.f); v0[e] = x * x; v1[e] = y * y; } }
        if constexpr (PROD) {
#pragma unroll
            for (int e = 0; e < 4; ++e) { s += v0[e] + v1[e]; ss += v0[e] * v0[e] + v1[e] * v1[e]; } }
        if constexpr (MODE == 5) { float* o = (float*)O + row * ldo + col; *(f32x4*)o = v0; *(f32x4*)(o + 4) = v1; }
        else *(u32x4*)((bf16_t*)O + row * ldo + col) = pack8(v0, v1);
    }
    __device__ __forceinline__ static void stats_of(const f32x2* st, size_t row, int h, float& s, float& ss) {
        const f32x4* sp = (const f32x4*)(st + row * 16 + h * 8); s = 0.f; ss = 0.f;
#pragma unroll
        for (int q = 0; q < 4; ++q) { const f32x4 v = sp[q]; s += v[0] + v[2]; ss += v[1] + v[3]; }
    }
    __device__ __forceinline__ void small(size_t row, int col, const f32x4 v0, const f32x4 v1) const {
        const f32x4 z = (f32x4){0.f, 0.f, 0.f, 0.f};
        float mean = 0.f, rstd = 0.f;
        if constexpr (CONS) { float s0, q0, s1, q1; stats_of(st_in, row, 0, s0, q0); stats_of(st_in, row, 1, s1, q1); mean = (s0 + s1) * (1.f / DM); rstd = __builtin_amdgcn_rsqf(fmaxf((q0 + q1) * (1.f / DM) - mean * mean, 0.f) + LN_EPS); }
        float s = 0.f, ss = 0.f;
        piece(row, col, v0, v1, CONS ? *(const f32x4*)(va + col) : z, CONS ? *(const f32x4*)(va + col + 4) : z, CONS ? *(const f32x4*)(vb + col) : z, CONS ? *(const f32x4*)(vb + col + 4) : z,
              (MODE == 5) ? *(const f32x4*)(bias + col) : z, (MODE == 5) ? *(const f32x4*)(bias + col + 4) : z, mean, rstd, s, ss);
        if constexpr (PROD) { s += __shfl_xor(s, 1); ss += __shfl_xor(ss, 1); s += __shfl_xor(s, 2); ss += __shfl_xor(ss, 2); s += __shfl_xor(s, 4); ss += __shfl_xor(ss, 4);
            if ((threadIdx.x & 7) == 0) st_out[row * 16 + (col >> 6)] = (f32x2){s, ss}; }
    }
    __device__ __forceinline__ void operator()(const f32x4 (&acc)[2][2][4][2], const Unit& u, int wr, int wc, int fr_, int fq_, LAS unsigned char* ldsx) const {
        int fr = fr_, fq = fq_; asm volatile("" : "+v"(fr), "+v"(fq));
        LAS f32x2* X = (LAS f32x2*)ldsx;
        X += (u.row0 == tag0) ? 0 : 256;
        const int colb = u.col0 + wc * 32 + 8 * fq;
        const f32x4 z = (f32x4){0.f, 0.f, 0.f, 0.f};
        f32x4 av[2][2], bv[2][2], cv[2][2];
#pragma unroll
        for (int bj = 0; bj < 2; ++bj)
#pragma unroll
            for (int n = 0; n < 2; ++n) { av[bj][n] = CONS ? *(const f32x4*)(va + colb + bj * HALF + 4 * n) : z; bv[bj][n] = CONS ? *(const f32x4*)(vb + colb + bj * HALF + 4 * n) : z;
                                          cv[bj][n] = (MODE == 5) ? *(const f32x4*)(bias + colb + bj * HALF + 4 * n) : z; }
#pragma unroll
        EPI_FOR_ROWS {
            const int rl = ai * HALF + wr * 64 + m * 16 + fr; const size_t row = (size_t)u.row0 + rl;
            float mean = 0.f, rstd = 0.f; if constexpr (CONS) { const f32x2 st = X[rl]; mean = st.x; rstd = st.y; }
            float s = 0.f, ss = 0.f;
#pragma unroll
            for (int bj = 0; bj < 2; ++bj) piece(row, colb + bj * HALF, acc[ai][bj][m][0], acc[ai][bj][m][1], av[bj][0], av[bj][1], bv[bj][0], bv[bj][1], cv[bj][0], cv[bj][1], mean, rstd, s, ss);
            if constexpr (PROD) { s += __shfl_xor(s, 16); ss += __shfl_xor(ss, 16); s += __shfl_xor(s, 32); ss += __shfl_xor(ss, 32);
                if (fq == 0) st_out[row * 16 + (u.col0 >> 8) * 4 + wc] = (f32x2){s, ss}; }
        }
    }
    template <class Sched> __device__ __forceinline__ void prep(const Sched& S, LAS unsigned char* ldsx) {
        Unit u; int t0 = 0, t1 = 0; bool any = S.next(0, u);
        if (any) { t0 = u.row0; t1 = t0; for (int i = 1; S.next(i, u); ++i) if (u.row0 != t0) { t1 = u.row0; break; } }
        tag0 = t0;
        if (any) {
            LAS f32x2* X = (LAS f32x2*)ldsx; int t = threadIdx.x; asm volatile("" : "+v"(t));
#pragma unroll
            for (int e = 0; e < 2; ++e) { float s, q; stats_of(st_in, (size_t)(e ? t1 : t0) + (t >> 1), t & 1, s, q);
                s += __shfl_xor(s, 1); q += __shfl_xor(q, 1);
                const float mean = s * (1.f / DM);
                if ((t & 1) == 0) X[e * 256 + (t >> 1)] = (f32x2){mean, __builtin_amdgcn_rsqf(fmaxf(q * (1.f / DM) - mean * mean, 0.f) + LN_EPS)}; }
        }
        __syncthreads();
    }
};
struct EpiWin {
    static constexpr bool PERM = true;
    bf16_t* Ub; bf16_t* Vb; float* out;
    __device__ __forceinline__ void conv_piece(size_t row, int ch, f32x4 v0, f32x4 v1, const f32x4 g0, const f32x4 g1) const {
#pragma unroll
        for (int e = 0; e < 4; ++e) { v0[e] *= sigmoidf_(g0[e]); v1[e] *= sigmoidf_(g1[e]); }
        *(u32x4*)(Vb + row * DCONV + ch) = pack8(v0, v1);
        float* dst = nullptr;
        if (row >= (size_t)NP) { const int r = (int)row - NP; dst = out + O_CVS + (size_t)((r >> 4) * 30 + 14 + (r & 15)) * DCONV + ch; }
        else { const int t = (int)row & (SEQ - 1); if (t >= SEQ - 30) dst = out + O_CVP + (size_t)(((int)row >> 14) * 30 + (t - (SEQ - 30))) * DCONV + ch; }
        if (dst) { *(f32x4*)dst = v0; *(f32x4*)(dst + 4) = v1; }
    }
    __device__ __forceinline__ void small(size_t row, int col, const f32x4 v0, const f32x4 v1) const { *(u32x4*)(Ub + row * DSSM + col) = pack8(v0, v1); }
    __device__ __forceinline__ void operator()(const f32x4 (&acc)[2][2][4][2], const Unit& u, int wr, int wc, int fr_, int fq_, LAS unsigned char*) const {
        int fr = fr_, fq = fq_; asm volatile("" : "+v"(fr), "+v"(fq));
        const int pn = u.aux;
#pragma unroll
        EPI_FOR_ROWS {
            const int rl = ai * HALF + wr * 64 + m * 16 + fr; const size_t row = (size_t)u.row0 + rl;
            if (pn < 2) {
#pragma unroll
                for (int bj = 0; bj < 2; ++bj) *(u32x4*)(Ub + row * DSSM + pn * 256 + bj * HALF + wc * 32 + 8 * fq) = pack8(acc[ai][bj][m][0], acc[ai][bj][m][1]);
            } else {
                conv_piece(row, (pn - 2) * 128 + wc * 32 + 8 * fq, acc[ai][0][m][0], acc[ai][0][m][1], acc[ai][1][m][0], acc[ai][1][m][1]);
            }
        }
    }
};
struct EpiKv {
    static constexpr bool PERM = true;
    bf16_t* Kb; bf16_t* Vt; float* out; int kind; bf16_t* V16;
    __device__ __forceinline__ void small(size_t row, int col, const f32x4 v0, const f32x4 v1) const {
        if (kind == 0) { float* o = out + O_MKP + row * DM + col; *(f32x4*)o = v0; *(f32x4*)(o + 4) = v1; *(u32x4*)(Kb + row * DM + col) = pack8(v0, v1); }
        else if (kind == 1) { float* o = out + O_MVP + row * DM + col; *(f32x4*)o = v0; *(f32x4*)(o + 4) = v1; *(u32x4*)(V16 + row * DM + col) = pack8(v0, v1); }
        else { const int b = col >> 8, key = col & 255; *(u32x4*)(Vt + (size_t)b * (DM * NMEM) + row * NMEM + key) = pack8(v0, v1); }
    }
};
struct EpiSoftmax {
    static constexpr bool PERM = true;
    bf16_t* P;
    __device__ __forceinline__ void operator()(f32x4 (&acc)[2][2][4][2], const Unit& u, int wr, int wc, int fr_, int fq_, LAS unsigned char* ldsx) const {
        int fr = fr_, fq = fq_; asm volatile("" : "+v"(fr), "+v"(fq));
        LAS f32x2* X = (LAS f32x2*)ldsx;
        float mx[2][4];
#pragma unroll
        EPI_FOR_ROWS {
            float mv = -3.0e38f;
#pragma unroll
            for (int bj = 0; bj < 2; ++bj)
#pragma unroll
                for (int n = 0; n < 2; ++n)
#pragma unroll
                    for (int e = 0; e < 4; ++e) mv = fmaxf(mv, acc[ai][bj][m][n][e]);
            mv = fmaxf(mv, __shfl_xor(mv, 16)); mv = fmaxf(mv, __shfl_xor(mv, 32));
            float s = 0.f;
#pragma unroll
            for (int bj = 0; bj < 2; ++bj)
#pragma unroll
                for (int n = 0; n < 2; ++n)
#pragma unroll
                    for (int e = 0; e < 4; ++e) { const float pe = __expf(acc[ai][bj][m][n][e] - mv); acc[ai][bj][m][n][e] = pe; s += pe; }
            s += __shfl_xor(s, 16); s += __shfl_xor(s, 32);
            mx[ai][m] = mv;
            if (fq == 0) X[(ai * HALF + wr * 64 + m * 16 + fr) * 4 + wc] = (f32x2){mv, s};
        }
        asm volatile("s_waitcnt lgkmcnt(0)" ::: "memory"); __builtin_amdgcn_s_barrier(); asm volatile("" ::: "memory");
#pragma unroll
        EPI_FOR_ROWS {
            const int rl = ai * HALF + wr * 64 + m * 16 + fr;
            const f32x2 a = X[rl * 4 + 0], b = X[rl * 4 + 1], c = X[rl * 4 + 2], d = X[rl * 4 + 3];
            const float M = fmaxf(fmaxf(a.x, b.x), fmaxf(c.x, d.x));
            const float Lsum = a.y * __expf(a.x - M) + b.y * __expf(b.x - M) + c.y * __expf(c.x - M) + d.y * __expf(d.x - M);
            const float sc = __expf(mx[ai][m] - M) * __builtin_amdgcn_rcpf(Lsum);
            if (u.nvalid >= 0 ? rl < u.nvalid : rl >= 256 + u.nvalid) {
                const size_t row = (size_t)u.row0 + rl;
#pragma unroll
                for (int bj = 0; bj < 2; ++bj) *(u32x4*)(P + row * DM + u.col0 + bj * HALF + wc * 32 + 8 * fq) = pack8(acc[ai][bj][m][0] * sc, acc[ai][bj][m][1] * sc);
            }
            asm volatile("" ::: "memory");
        }
        asm volatile("s_waitcnt lgkmcnt(0)" ::: "memory"); __builtin_amdgcn_s_barrier(); asm volatile("" ::: "memory");
    }
};
}

template <class Epi, bool PAIR>
__device__ __forceinline__ void small_gemm(LAS unsigned char* lds, const bf16_t* A, int lda, const bf16_t* B, int ldb, int K, int nrg, int nct, size_t row_base, int col_base, const Epi& E, int G, int c) {
    int tid = threadIdx.x; asm volatile("" : "+v"(tid));
    const int wid = __builtin_amdgcn_readfirstlane(tid >> 6), lane = tid & 63, fr = lane & 15, fq = lane >> 4;
    LAS float* red = (LAS float*)lds;
    const int kw = K >> 3, k0 = wid * kw, nks = kw >> 5;
    for (int unit = c; unit < nrg * nct; unit += G) {
        const int rg = unit % nrg, ct = unit / nrg;
        f32x4 acc[4][4];
#pragma unroll
        for (int mi = 0; mi < 4; ++mi)
#pragma unroll
            for (int ni = 0; ni < 4; ++ni) acc[mi][ni] = (f32x4){0.f, 0.f, 0.f, 0.f};
        const bf16_t* ap = A + (size_t)(rg * 64 + fr) * lda + k0 + fq * 8;
        const bf16_t* bp;
        if (PAIR) { const int ch0 = 32 * ct; bp = B + (size_t)(DSSM + 256 * (ch0 >> 7) + (ch0 & 127) + fr) * ldb + k0 + fq * 8; }
        else bp = B + (size_t)(ct * 64 + fr) * ldb + k0 + fq * 8;
#pragma unroll 4
        for (int ks = 0; ks < nks; ++ks) {
            bf16x8 a[4], b[4];
#pragma unroll
            for (int mi = 0; mi < 4; ++mi) a[mi] = *(const bf16x8*)(ap + (size_t)(mi * 16) * lda + ks * 32);
#pragma unroll
            for (int ni = 0; ni < 4; ++ni) { const int roff = PAIR ? ((ni & 1) * 16 + (ni >> 1) * 128) : ni * 16; b[ni] = *(const bf16x8*)(bp + (size_t)roff * ldb + ks * 32); }
#pragma unroll
            for (int mi = 0; mi < 4; ++mi)
#pragma unroll
                for (int ni = 0; ni < 4; ++ni) acc[mi][ni] = __builtin_amdgcn_mfma_f32_16x16x32_bf16(b[ni], a[mi], acc[mi][ni], 0, 0, 0);
        }
        __syncthreads();
#pragma unroll
        for (int mi = 0; mi < 4; ++mi)
#pragma unroll
            for (int ni = 0; ni < 4; ++ni) *(LAS f32x4*)(red + (wid * 64 + mi * 16 + fr) * 68 + ni * 16 + 4 * fq) = acc[mi][ni];
        __syncthreads();
        if constexpr (!PAIR) {
            const int r = tid >> 3, pc = tid & 7; f32x4 v0 = (f32x4){0.f, 0.f, 0.f, 0.f}, v1 = v0;
#pragma unroll
            for (int w = 0; w < 8; ++w) { v0 += *(const LAS f32x4*)(red + (w * 64 + r) * 68 + pc * 8); v1 += *(const LAS f32x4*)(red + (w * 64 + r) * 68 + pc * 8 + 4); }
            E.small(row_base + rg * 64 + r, col_base + ct * 64 + pc * 8, v0, v1);
        } else { if (tid < 256) {
            const int r = tid >> 2, pc = tid & 3; f32x4 v0 = (f32x4){0.f, 0.f, 0.f, 0.f}, v1 = v0, g0 = v0, g1 = v0;
#pragma unroll
            for (int w = 0; w < 8; ++w) { const LAS float* q = red + (w * 64 + r) * 68 + pc * 8;
                v0 += *(const LAS f32x4*)q; v1 += *(const LAS f32x4*)(q + 4); g0 += *(const LAS f32x4*)(q + 32); g1 += *(const LAS f32x4*)(q + 36); }
            E.conv_piece(row_base + rg * 64 + r, 32 * ct + pc * 8, v0, v1, g0, g1);
        } }
    }
    __syncthreads();
}

struct Frame {
    LAS unsigned char* lds; int tid, lane, wave, G, vcu;
};
__device__ __forceinline__ Frame fresh(const Frame& F0) { Frame F = F0; int t = threadIdx.x; asm volatile("" : "+v"(t)); F.tid = t; F.lane = t & 63; F.wave = __builtin_amdgcn_readfirstlane(t >> 6); return F; }

__device__ __forceinline__ void transpose_item(const float* W, int K, int N, bf16_t* WT, int ldt, int k0, int n0, int drow0, LAS float* scr, int lane,
                                               const float* gam = nullptr, const float* bet = nullptr, float* csp = nullptr, float* bcp = nullptr) {
    float tv[32];
#pragma unroll
    for (int i = 0; i < 32; ++i) tv[i] = __builtin_nontemporal_load(W + (size_t)(k0 + 2 * i + (lane >> 5)) * N + n0 + (lane & 31));
#pragma unroll
    for (int i = 0; i < 32; ++i) scr[(2 * i + (lane >> 5)) * 33 + (lane & 31)] = tv[i];
    asm volatile("s_waitcnt lgkmcnt(0)" ::: "memory");
    const int c = lane & 7;
    float ge[8], be[8];
#pragma unroll
    for (int e = 0; e < 8; ++e) { ge[e] = gam ? gam[k0 + 8 * c + e] : 1.f; be[e] = gam ? bet[k0 + 8 * c + e] : 0.f; }
#pragma unroll
    for (int j = 0; j < 4; ++j) { const int n = (lane >> 3) + 8 * j; const LAS float* sp = scr + (8 * c) * 33 + n;
        float w[8];
#pragma unroll
        for (int e = 0; e < 8; ++e) w[e] = sp[e * 33];
        u32x4 o; o.x = cvt_pk_bf16(w[0] * ge[0], w[1] * ge[1]); o.y = cvt_pk_bf16(w[2] * ge[2], w[3] * ge[3]); o.z = cvt_pk_bf16(w[4] * ge[4], w[5] * ge[5]); o.w = cvt_pk_bf16(w[6] * ge[6], w[7] * ge[7]);
        *(u32x4*)(WT + (size_t)(drow0 + n) * ldt + k0 + 8 * c) = o;
        if (gam) {
            float cs = (bf_lo(o.x) + bf_hi(o.x)) + (bf_lo(o.y) + bf_hi(o.y)) + (bf_lo(o.z) + bf_hi(o.z)) + (bf_lo(o.w) + bf_hi(o.w)), bc = 0.f;
#pragma unroll
            for (int e = 0; e < 8; ++e) bc += w[e] * be[e];
            cs += __shfl_xor(cs, 1); cs += __shfl_xor(cs, 2); cs += __shfl_xor(cs, 4); bc += __shfl_xor(bc, 1); bc += __shfl_xor(bc, 2); bc += __shfl_xor(bc, 4);
            if (c == 0) { csp[(size_t)(k0 >> 6) * N + n0 + n] = cs; bcp[(size_t)(k0 >> 6) * N + n0 + n] = bc; }
        }
    }
    asm volatile("s_waitcnt lgkmcnt(0)" ::: "memory");
}
__device__ __forceinline__ int win_dest_row(int n0) {
    if (n0 < DSSM) return n0;
    const int cc = n0 - DSSM;
    if (cc < DCONV) return DSSM + 256 * (cc >> 7) + (cc & 127);
    const int c2 = cc - DCONV; return DSSM + 256 * (c2 >> 7) + 128 + (c2 & 127);
}

__device__ __forceinline__ void ssm_tables(const Params& p, int g, int part, LAS float* sm, int tid) {
    LAS float* pwr = sm;
    LAS float* pwi = sm + 576;
    LAS float* cfr = sm + 1152;
    LAS float* cfi = sm + 1216;
    LAS float* bbr = sm + 1280;
    LAS float* bbi = sm + 2304;
    LAS float* cre = sm + 3328;
    LAS float* cim = sm + 4352;
    LAS float* kc = sm + 5376;
    const float* a_re = p.in[9] + g * 64; const float* a_im = p.in[10] + g * 64; const float* b_re = p.in[12] + (size_t)g * 1024; const float* b_im = p.in[13] + (size_t)g * 1024;
    const float* c_re = p.in[14] + (size_t)g * 1024; const float* c_im = p.in[15] + (size_t)g * 1024;
    const int fa = 12 * part, fb = fa + 12;
    __syncthreads();
    if (tid < 64) {
        const float are = a_re[tid], aim = a_im[tid], dt = expf(p.in[11][g]);
        const float mag = expf(are * dt), ang = aim * dt;
        float sn, cs; sincosf(ang, &sn, &cs);
        const float abr = mag * cs, abi = mag * sn, den = are * are + aim * aim, pp = abr - 1.f, q = abi;
        cfr[tid] = (pp * are + q * aim) / den; cfi[tid] = (q * are - pp * aim) / den;
        float xr = 1.f, xi = 0.f;
#pragma unroll
        for (int k = 0; k < 9; ++k) { pwr[k * 64 + tid] = xr; pwi[k * 64 + tid] = xi; const float nr = xr * abr - xi * abi, ni = xr * abi + xi * abr; xr = nr; xi = ni; }
        if (part == 0) ((f32x2*)(p.ws + WS_M1))[g * 64 + tid] = (f32x2){pwr[8 * 64 + tid], pwi[8 * 64 + tid]};
    }
    for (int e = tid; e < 1024; e += 512) { cre[e] = c_re[e]; cim[e] = c_im[e]; }
    __syncthreads();
    for (int e = tid; e < 1024; e += 512) { const int n = e >> 4; const float br = b_re[e], bi = b_im[e]; bbr[e] = cfr[n] * br - cfi[n] * bi; bbi[e] = cfr[n] * bi + cfi[n] * br; }
    __syncthreads();
    if (fa < 64 && fb > 32) {
        for (int e = tid; e < 2048; e += 512) { const int l = e >> 8, pch = (e >> 4) & 15, q = e & 15; float s = 0.f;
            for (int n = 0; n < 64; ++n) { const float cr = cre[pch * 64 + n], ci = cim[pch * 64 + n], ar = pwr[l * 64 + n], ai = pwi[l * 64 + n];
                const float zr = cr * ar - ci * ai, zi = cr * ai + ci * ar; s += zr * bbr[n * 16 + q] - zi * bbi[n * 16 + q]; }
            kc[e] = s; }
    }
    __syncthreads();
    bf16_t* dst = (bf16_t*)(p.ws + WS_SSMW) + (size_t)g * SSM_FRAG_ELEMS;
    for (int e = fa * 512 + tid; e < fb * 512; e += 512) {
        const int f = e >> 9, l = (e >> 3) & 63, ee = e & 7, lo = l & 15, gq = l >> 4; float v;
        if (f < 32) { const int i = f >> 2, ks = f & 3, np = 16 * i + lo, k = 32 * ks + 8 * gq + ee, sI = k >> 4, q = k & 15, n = np & 63;
            const float ar = pwr[(7 - sI) * 64 + n], ai = pwi[(7 - sI) * 64 + n], br = bbr[n * 16 + q], bi = bbi[n * 16 + q];
            v = (np < 64) ? (ar * br - ai * bi) : (ar * bi + ai * br); }
        else if (f < 64) { const int t = (f - 32) >> 2, ks = (f - 32) & 3, k = 32 * ks + 8 * gq + ee, sI = k >> 4, q = k & 15;
            v = (sI <= t) ? kc[(t - sI) * 256 + lo * 16 + q] : 0.f; }
        else { const int t = (f - 64) >> 2, kap = (f - 64) & 3, tile = (ee < 4) ? 2 * kap : 2 * kap + 1, np = 16 * tile + 4 * gq + (ee & 3), n = np & 63;
            const float cr = cre[lo * 64 + n], ci = cim[lo * 64 + n], ar = pwr[(t + 1) * 64 + n], ai = pwi[(t + 1) * 64 + n];
            v = (np < 64) ? (cr * ar - ci * ai) : -(cr * ai + ci * ar); }
        dst[e] = f2bf(v);
    }
}

__device__ __forceinline__ void p0_prologue(const Params& p, const Frame& F0) {
    const Frame F = fresh(F0);
    LAS float* scr = (LAS float*)(F.lds + F.wave * 16384);
    const int gw = F.vcu * 8 + F.wave, NGW = F.G * 8;
    bf16_t* Win_t = (bf16_t*)(p.ws + WS_WIN); bf16_t* Glu_t = (bf16_t*)(p.ws + WS_GLU); bf16_t* Wout_t = (bf16_t*)(p.ws + WS_WOUT); bf16_t* Wq_t = (bf16_t*)(p.ws + WS_WQ);
    bf16_t* Wkv_t = (bf16_t*)(p.ws + WS_WKV); bf16_t* Wo_t = (bf16_t*)(p.ws + WS_WO); bf16_t* W1_t = (bf16_t*)(p.ws + WS_W1); bf16_t* W2_t = (bf16_t*)(p.ws + WS_W2);
    bf16_t* Vt = (bf16_t*)(p.ws + WS_VT);
    constexpr int I_IN = 16 * 48, I_GLU = 8 * 16, I_SQ = 16 * 32, I_1 = 16 * 128, I_2 = 64 * 32, I_VT = 16 * 4 * 32;
    constexpr int NITEMS = I_IN + I_GLU + 5 * I_SQ + I_1 + I_2 + I_VT;
    for (int it = gw; it < NITEMS; it += NGW) {
        int r = it;
        if (r < I_IN) { const int kb = r / 48, nb = r % 48; transpose_item(p.in[8], DM, DIN, Win_t, DM, 64 * kb, 32 * nb, win_dest_row(32 * nb), scr, F.lane); continue; } r -= I_IN;
        if (r < I_GLU) { const int kb = r / 16, nb = r % 16; transpose_item(p.in[17], DSSM, DSSM, Glu_t, DSSM, 64 * kb, 32 * nb, 32 * nb, scr, F.lane); continue; } r -= I_GLU;
        if (r < 5 * I_SQ) { const int w = r / I_SQ, q = r % I_SQ, kb = q / 32, nb = q % 32;
            const float* src = w == 0 ? p.in[23] : w == 1 ? p.in[26] : w == 2 ? p.in[27] : w == 3 ? p.in[28] : p.in[29];
            bf16_t* dst = w == 0 ? Wout_t : w == 1 ? Wq_t : w == 2 ? Wkv_t : w == 3 ? Wkv_t + (size_t)DM * DM : Wo_t;
            float* csp = (float*)(p.ws + WS_CSP);
            if (w == 1) transpose_item(src, DM, DM, dst, DM, 64 * kb, 32 * nb, 32 * nb, scr, F.lane, p.in[24], p.in[25], csp, csp + 16 * DM);
            else transpose_item(src, DM, DM, dst, DM, 64 * kb, 32 * nb, 32 * nb, scr, F.lane);
            continue; } r -= 5 * I_SQ;
        if (r < I_1) { const int kb = r / 128, nb = r % 128; float* csp = (float*)(p.ws + WS_CSP) + 32 * DM; transpose_item(p.in[32], DM, DFF, W1_t, DM, 64 * kb, 32 * nb, 32 * nb, scr, F.lane, p.in[30], p.in[31], csp, csp + 16 * DFF); continue; } r -= I_1;
        if (r < I_2) { const int kb = r / 32, nb = r % 32; transpose_item(p.in[34], DFF, DM, W2_t, DFF, 64 * kb, 32 * nb, 32 * nb, scr, F.lane); continue; } r -= I_2;
        { const int js = r / 128, q = r % 128, kb = q / 32, nb = q % 32;
          transpose_item(p.in[6] + (size_t)js * NMEM * DM, NMEM, DM, Vt + (size_t)(2 + js) * DM * NMEM, NMEM, 64 * kb, 32 * nb, 32 * nb, scr, F.lane); }
    }
    {
        const size_t gt = (size_t)F.vcu * 512 + F.tid, NT = (size_t)F.G * 512;
        bf16_t* Xb = (bf16_t*)(p.ws + WS_XB); bf16_t* Kb = (bf16_t*)(p.ws + WS_KB); bf16_t* Mb = (bf16_t*)(p.ws + WS_MEMB);
        constexpr size_t C_X = (size_t)R * DM / 8, C_XP = (size_t)NP * DM / 8, C_K = (size_t)NSB * NMEM * DM / 8, C_M = (size_t)NB * NMEM * DM / 8;
        constexpr size_t C_ALL = C_X + C_K + C_M;
        for (size_t i0 = gt; i0 < C_ALL; i0 += 4 * NT) {
            f32x4 a[4], b[4]; bf16_t* dst[4]; bool ok[4];
#pragma unroll
            for (int q = 0; q < 4; ++q) {
                const size_t i = i0 + q * NT; ok[q] = i < C_ALL; const size_t ic = ok[q] ? i : gt; const float* src;
                if (ic < C_X) { src = (ic < C_XP) ? p.in[0] + ic * 8 : p.in[1] + (ic - C_XP) * 8; dst[q] = Xb + ic * 8; }
                else if (ic < C_X + C_K) { const size_t k = ic - C_X; src = p.in[5] + k * 8; dst[q] = Kb + (size_t)NB * NMEM * DM + k * 8; }
                else { const size_t k = ic - C_X - C_K; src = p.in[7] + k * 8; dst[q] = Mb + k * 8; }
                a[q] = __builtin_nontemporal_load((const f32x4*)src); b[q] = __builtin_nontemporal_load((const f32x4*)(src + 4));
            }
#pragma unroll
            for (int q = 0; q < 4; ++q) if (ok[q]) *(u32x4*)dst[q] = pg8::pack8(a[q], b[q]);
        }
        for (size_t i = gt; i < (size_t)NSB * 14 * DCONV / 4; i += NT) { const size_t e = i * 4, js = e / (14 * DCONV), rem = e % (14 * DCONV);
            *(f32x4*)(p.out + O_CVS + js * 30 * DCONV + rem) = *(const f32x4*)(p.in[4] + js * 30 * DCONV + 16 * DCONV + rem); }
    }
    for (int w = blockIdx.x; w < NG * 8; w += F.G) ssm_tables(p, w & (NG - 1), w >> 5, (LAS float*)F.lds, F.tid);
    __syncthreads();
}

template <bool PASS2>
__device__ __forceinline__ void ssm_phase(const Params& p, const Frame& F0) {
    const Frame F = fresh(F0);
    const bf16_t* Ub = (const bf16_t*)(p.ws + WS_UB); bf16_t* Zb = (bf16_t*)(p.ws + WS_ZB);
    float* Wst = (float*)(p.ws + WS_WST);
    const int lane = F.lane, j = lane & 15, gq = lane >> 4;
    for (int pr = blockIdx.x; pr < 256; pr += F.G) {
        const int g = 4 * (pr & 7) + ((pr >> 3) & 3), subset = pr >> 5;
        __syncthreads();
        { const u32x4* src = (const u32x4*)((const bf16_t*)(p.ws + WS_SSMW) + (size_t)g * SSM_FRAG_ELEMS);
          for (int e = F.tid; e < SSM_FRAG_ELEMS / 8; e += 512) ((LAS u32x4*)F.lds)[e] = src[e];
          if (F.tid < 64) ((LAS f32x2*)(F.lds + SSM_M1_OFF))[F.tid] = ((const f32x2*)(p.ws + WS_M1))[g * 64 + F.tid]; }
        __syncthreads();
        const LAS bf16x8* frag = (const LAS bf16x8*)F.lds + lane;
        const LAS f32x4* m1t = (const LAS f32x4*)(F.lds + SSM_M1_OFF) + 2 * gq;
        const int b = subset >> 2, wch = (subset & 3) * 8 + F.wave;
        f32x4 xs[8];
#pragma unroll
        for (int i = 0; i < 8; ++i) xs[i] = (f32x4){0.f, 0.f, 0.f, 0.f};
        if (PASS2 && wch > 0) {
            const float* wb = Wst + (size_t)((g * 2 + b) * 32) * 128;
#pragma unroll
            for (int i = 0; i < 4; ++i) {
                __builtin_amdgcn_sched_barrier(0);
                const f32x4 ma = m1t[8 * i], mb = m1t[8 * i + 1];
                float pr_[4] = {ma[0], ma[2], mb[0], mb[2]}, pi_[4] = {ma[1], ma[3], mb[1], mb[3]};
#pragma unroll
                for (int r = 0; r < 4; ++r) {
#pragma unroll
                    for (int s2 = 0; s2 < 6; ++s2) { const float nr = pr_[r] * pr_[r] - pi_[r] * pi_[r], ni = 2.f * pr_[r] * pi_[r]; pr_[r] = nr; pi_[r] = ni; } }
                f32x4 wre[2], wim[2]; int ex[2];
#pragma unroll
                for (int e = 0; e < 2; ++e) { const int w = j + 16 * e; const bool ok = w < wch; ex[e] = ok ? (wch - 1 - w) : 0; const int wc_ = ok ? w : 0;
                    const f32x4 lr = *(const f32x4*)(wb + wc_ * 128 + 16 * i + 4 * gq), li = *(const f32x4*)(wb + wc_ * 128 + 64 + 16 * i + 4 * gq);
                    wre[e] = ok ? lr : (f32x4){0.f, 0.f, 0.f, 0.f}; wim[e] = ok ? li : (f32x4){0.f, 0.f, 0.f, 0.f}; }
                float fr_[2][4], fi_[2][4];
#pragma unroll
                for (int e = 0; e < 2; ++e)
#pragma unroll
                    for (int r = 0; r < 4; ++r) { fr_[e][r] = 1.f; fi_[e][r] = 0.f; }
#pragma unroll
                for (int bit = 0; bit < 5; ++bit) {
#pragma unroll
                    for (int e = 0; e < 2; ++e) { const bool on = (ex[e] >> bit) & 1;
#pragma unroll
                        for (int r = 0; r < 4; ++r) { const float qr = on ? pr_[r] : 1.f, qi = on ? pi_[r] : 0.f;
                            const float nr = fr_[e][r] * qr - fi_[e][r] * qi, ni = fr_[e][r] * qi + fi_[e][r] * qr; fr_[e][r] = nr; fi_[e][r] = ni; } }
                    if (bit < 4) {
#pragma unroll
                        for (int r = 0; r < 4; ++r) { const float nr = pr_[r] * pr_[r] - pi_[r] * pi_[r], ni = 2.f * pr_[r] * pi_[r]; pr_[r] = nr; pi_[r] = ni; } }
                }
                f32x4 hr, hi;
#pragma unroll
                for (int r = 0; r < 4; ++r) { hr[r] = fr_[0][r] * wre[0][r] - fi_[0][r] * wim[0][r] + fr_[1][r] * wre[1][r] - fi_[1][r] * wim[1][r];
                                              hi[r] = fr_[0][r] * wim[0][r] + fi_[0][r] * wre[0][r] + fr_[1][r] * wim[1][r] + fi_[1][r] * wre[1][r]; }
#pragma unroll
                for (int r = 0; r < 4; ++r) { hr[r] += dppf<DPP_SHR(1)>(hr[r]); hi[r] += dppf<DPP_SHR(1)>(hi[r]); hr[r] += dppf<DPP_SHR(2)>(hr[r]); hi[r] += dppf<DPP_SHR(2)>(hi[r]);
                                              hr[r] += dppf<DPP_SHR(4)>(hr[r]); hi[r] += dppf<DPP_SHR(4)>(hi[r]); hr[r] += dppf<DPP_SHR(8)>(hr[r]); hi[r] += dppf<DPP_SHR(8)>(hi[r]); }
                xs[i] = hr; xs[i + 4] = hi;
            }
        }
        const int nch = 4 + ((PASS2 && F.wave < 2) ? 1 : 0);
        const int jsamp = subset * 2 + F.wave;
#define SSM_ROW0(cc_) (((cc_) == 4) ? (NP + jsamp * NST) : (b * SEQ + (wch * 4 + (cc_)) * 128))
#define SSM_NSUB(cc_) (((cc_) == 4) ? 2 : 16)
#define SSM_LOAD_U(dst, dstu, cc_) { const int r0_ = SSM_ROW0(cc_), ns_ = SSM_NSUB(cc_); const bool ok_ = j < ns_; const int jj_ = ok_ ? j : 0; \
            _Pragma("unroll") for (int ks = 0; ks < 4; ++ks) { const int s_ = 2 * ks + (gq >> 1); \
                const bf16x8 v_ = *(const bf16x8*)(Ub + (size_t)(r0_ + 8 * jj_ + s_) * DSSM + g * 16 + 8 * (gq & 1)); dst[ks] = ok_ ? v_ : (bf16x8){0, 0, 0, 0, 0, 0, 0, 0}; } \
            if (PASS2) { _Pragma("unroll") for (int t = 0; t < 8; ++t) dstu[t] = *(const u32x2*)(Ub + (size_t)(r0_ + 8 * jj_ + t) * DSSM + g * 16 + 4 * gq); } }
        bf16x8 uf[4], ufn[4]; u32x2 uw[8], uwn[8];
        SSM_LOAD_U(uf, uw, 0)
        for (int cc = 0; cc < nch; ++cc) {
            asm volatile("" ::: "memory");
            const bool samp = (cc == 4);
            const int row0 = SSM_ROW0(cc), nsub = SSM_NSUB(cc), js = jsamp;
            if (samp) {
#pragma unroll
                for (int i = 0; i < 4; ++i) { xs[i] = *(const f32x4*)(p.in[2] + (size_t)(js * NG + g) * 64 + 16 * i + 4 * gq); xs[i + 4] = *(const f32x4*)(p.in[3] + (size_t)(js * NG + g) * 64 + 16 * i + 4 * gq); } }
            if (cc + 1 < nch) SSM_LOAD_U(ufn, uwn, cc + 1)
            unsigned hw[4][4];
#pragma unroll
            for (int i = 0; i < 4; ++i) {
                __builtin_amdgcn_sched_barrier(0);
                f32x4 Er = (f32x4){0.f, 0.f, 0.f, 0.f}, Ei = Er;
#pragma unroll
                for (int ks = 0; ks < 4; ++ks) { Er = __builtin_amdgcn_mfma_f32_16x16x32_bf16(frag[(i * 4 + ks) * 64], uf[ks], Er, 0, 0, 0);
                                                 Ei = __builtin_amdgcn_mfma_f32_16x16x32_bf16(frag[((i + 4) * 4 + ks) * 64], uf[ks], Ei, 0, 0, 0); }
                const f32x4 ma = m1t[8 * i], mb = m1t[8 * i + 1];
                float mr[4] = {ma[0], ma[2], mb[0], mb[2]}, mi[4] = {ma[1], ma[3], mb[1], mb[3]};
                float hr[4], hi[4];
#pragma unroll
                for (int r = 0; r < 4; ++r) { hr[r] = dppf<DPP_ROR(1)>(xs[i][r]); hi[r] = dppf<DPP_ROR(1)>(xs[i + 4][r]);
                    if (j == 0) { Er[r] += mr[r] * hr[r] - mi[r] * hi[r]; Ei[r] += mr[r] * hi[r] + mi[r] * hr[r]; } }
#define SSM_SCAN_STEP(D, SQ) { _Pragma("unroll") for (int r = 0; r < 4; ++r) { \
                    const float sr = dppf<DPP_SHR(D)>(Er[r]), si = dppf<DPP_SHR(D)>(Ei[r]); \
                    Er[r] += mr[r] * sr - mi[r] * si; Ei[r] += mr[r] * si + mi[r] * sr; \
                    if (SQ) { const float nr = mr[r] * mr[r] - mi[r] * mi[r], ni = 2.f * mr[r] * mi[r]; mr[r] = nr; mi[r] = ni; } } }
                SSM_SCAN_STEP(1, 1) SSM_SCAN_STEP(2, 1) SSM_SCAN_STEP(4, 1) SSM_SCAN_STEP(8, 0)
#undef SSM_SCAN_STEP
                if constexpr (PASS2) {
                    float vr[4], vi[4];
#pragma unroll
                    for (int r = 0; r < 4; ++r) { const float pr_ = dppf<DPP_ROR(1)>(Er[r]), pi_ = dppf<DPP_ROR(1)>(Ei[r]); vr[r] = (j == 0) ? hr[r] : pr_; vi[r] = (j == 0) ? hi[r] : pi_; }
                    hw[i >> 1][2 * (i & 1)] = cvt_pk_bf16(vr[0], vr[1]); hw[i >> 1][2 * (i & 1) + 1] = cvt_pk_bf16(vr[2], vr[3]);
                    hw[2 + (i >> 1)][2 * (i & 1)] = cvt_pk_bf16(vi[0], vi[1]); hw[2 + (i >> 1)][2 * (i & 1) + 1] = cvt_pk_bf16(vi[2], vi[3]);
                }
                xs[i] = Er; xs[i + 4] = Ei;
            }
            __builtin_amdgcn_sched_barrier(0);
            asm volatile("" ::: "memory");
            if constexpr (PASS2) {
                bf16x8 hf[4];
#pragma unroll
                for (int kap = 0; kap < 4; ++kap) hf[kap] = __builtin_bit_cast(bf16x8, (u32x4){hw[kap][0], hw[kap][1], hw[kap][2], hw[kap][3]});
                const f32x4 dv = *(const f32x4*)(p.in[16] + g * 16 + 4 * gq);
#pragma unroll
                for (int t = 0; t < 8; ++t) {
                    asm volatile("" ::: "memory");
                    f32x4 y = (f32x4){0.f, 0.f, 0.f, 0.f};
#pragma unroll
                    for (int ks = 0; ks < 4; ++ks) y = __builtin_amdgcn_mfma_f32_16x16x32_bf16(frag[(32 + t * 4 + ks) * 64], uf[ks], y, 0, 0, 0);
#pragma unroll
                    for (int kap = 0; kap < 4; ++kap) y = __builtin_amdgcn_mfma_f32_16x16x32_bf16(frag[(64 + t * 4 + kap) * 64], hf[kap], y, 0, 0, 0);
                    if (j < nsub) {
                        const size_t off = (size_t)(row0 + 8 * j + t) * DSSM + g * 16 + 4 * gq;
                        const u32x2 uu = uw[t];
                        const float z0 = gelu_tanh(y[0] + dv[0] * bf_lo(uu.x)), z1 = gelu_tanh(y[1] + dv[1] * bf_hi(uu.x)), z2 = gelu_tanh(y[2] + dv[2] * bf_lo(uu.y)), z3 = gelu_tanh(y[3] + dv[3] * bf_hi(uu.y));
                        *(u32x2*)(Zb + off) = (u32x2){cvt_pk_bf16(z0, z1), cvt_pk_bf16(z2, z3)};
                    }
                }
                if (samp) { if (j == 1) {
#pragma unroll
                        for (int i = 0; i < 4; ++i) { *(f32x4*)(p.out + O_SRS + (size_t)(js * NG + g) * 64 + 16 * i + 4 * gq) = xs[i]; *(f32x4*)(p.out + O_SIS + (size_t)(js * NG + g) * 64 + 16 * i + 4 * gq) = xs[i + 4]; } } }
                else if (cc == 3 && wch == 31 && j == 15) {
#pragma unroll
                    for (int i = 0; i < 4; ++i) { *(f32x4*)(p.out + O_SRP + (size_t)(b * NG + g) * 64 + 16 * i + 4 * gq) = xs[i]; *(f32x4*)(p.out + O_SIP + (size_t)(b * NG + g) * 64 + 16 * i + 4 * gq) = xs[i + 4]; }
                }
            }
#pragma unroll
            for (int ks = 0; ks < 4; ++ks) uf[ks] = ufn[ks];
            if (PASS2) {
#pragma unroll
                for (int t = 0; t < 8; ++t) uw[t] = uwn[t]; }
        }
#undef SSM_ROW0
#undef SSM_NSUB
#undef SSM_LOAD_U
        if constexpr (!PASS2) { if (j == 15) { float* wb = Wst + (size_t)((g * 2 + b) * 32 + wch) * 128;
#pragma unroll
                for (int i = 0; i < 4; ++i) { *(f32x4*)(wb + 16 * i + 4 * gq) = xs[i]; *(f32x4*)(wb + 64 + 16 * i + 4 * gq) = xs[i + 4]; } } }
    }
    __syncthreads();
}

template <int PMODE>
__device__ __forceinline__ void conv_phase(const Params& p, const Frame& F0) {
    const Frame F = fresh(F0);
    const bf16_t* Vb = (const bf16_t*)(p.ws + WS_VB); bf16_t* Cat = (bf16_t*)(p.ws + WS_CAT);
    LAS float* red = (LAS float*)F.lds;
    LAS f32x2* stat = (LAS f32x2*)(F.lds + 64 * 264 * 4);
    const int hb = F.tid >> 8, tt = F.tid & 255, c0 = 2 * tt;
    f32x2 cw[CW];
#pragma unroll
    for (int w = 0; w < CW; ++w) cw[w] = *(const f32x2*)(p.in[19] + w * DCONV + c0);
    const f32x2 cb = *(const f32x2*)(p.in[20] + c0), lg = *(const f32x2*)(p.in[21] + c0), lb = *(const f32x2*)(p.in[22] + c0);
    unsigned wp0[16], wp1[16];
#pragma unroll
    for (int m = 0; m < 16; ++m) { wp0[m] = cvt_pk_bf16(cw[2 * m].x, (2 * m + 1 < CW) ? cw[2 * m + 1 < CW ? 2 * m + 1 : 0].x : 0.f); wp1[m] = cvt_pk_bf16(cw[2 * m].y, (2 * m + 1 < CW) ? cw[2 * m + 1 < CW ? 2 * m + 1 : 0].y : 0.f); }
    unsigned wv[46];
#define CONV_LOAD(unit_) { const int row0_ = (unit_) * 32 + hb * 16; \
        if ((unit_) < NP / 32) { const int t0_ = row0_ & (SEQ - 1); \
            _Pragma("unroll") for (int i = 0; i < 46; ++i) { const bool ok_ = (t0_ - 30 + i) >= 0; const int rr_ = ok_ ? (row0_ - 30 + i) : row0_; \
                const unsigned w_ = *(const unsigned*)(Vb + (size_t)rr_ * DCONV + c0); wv[i] = ok_ ? w_ : 0u; } } \
        else { const int js_ = (row0_ - NP) >> 4; \
            _Pragma("unroll") for (int i = 0; i < 30; ++i) { const f32x2 h_ = *(const f32x2*)(p.in[4] + (size_t)(js_ * 30 + i) * DCONV + c0); wv[i] = cvt_pk_bf16(h_.x, h_.y); } \
            _Pragma("unroll") for (int i = 30; i < 46; ++i) wv[i] = *(const unsigned*)(Vb + (size_t)(row0_ - 30 + i) * DCONV + c0); } }
    if ((int)blockIdx.x < R / 32) CONV_LOAD((int)blockIdx.x)
    for (int unit = blockIdx.x; unit < R / 32; unit += F.G) {
        const int row0 = unit * 32 + hb * 16;
        unsigned P0[46], P1[46];
#pragma unroll
        for (int i = 0; i < 45; ++i) { P0[i] = __builtin_amdgcn_perm(wv[i + 1], wv[i], 0x05040100u); P1[i] = __builtin_amdgcn_perm(wv[i + 1], wv[i], 0x07060302u); }
        P0[45] = wv[45] & 0xffffu; P1[45] = wv[45] >> 16;
        f32x2 acc[16];
#pragma unroll
        for (int k = 0; k < 16; ++k) {
            float a0 = cb.x, a1 = cb.y;
#pragma unroll
            for (int m = 0; m < 16; ++m) {
                a0 = __builtin_amdgcn_fdot2_f32_bf16(__builtin_bit_cast(bf16v2, P0[k + 2 * m]), __builtin_bit_cast(bf16v2, wp0[m]), a0, false);
                a1 = __builtin_amdgcn_fdot2_f32_bf16(__builtin_bit_cast(bf16v2, P1[k + 2 * m]), __builtin_bit_cast(bf16v2, wp1[m]), a1, false);
            }
            acc[k] = (f32x2){a0, a1};
        }
        if (unit + F.G < R / 32) CONV_LOAD(unit + F.G)
        if constexpr (PMODE != 0) { float sk = 0.f;
#pragma unroll
            for (int k = 0; k < 16; ++k) sk += acc[k].x + acc[k].y;
            if (sk == 12345.678f) Cat[0] = 0; continue; }
        LDS_BARRIER();
#pragma unroll
        for (int k = 0; k < 16; ++k) { red[((hb * 32 + k) * 8 + (tt >> 5)) * 33 + (tt & 31)] = acc[k].x + acc[k].y; red[((hb * 32 + 16 + k) * 8 + (tt >> 5)) * 33 + (tt & 31)] = acc[k].x * acc[k].x + acc[k].y * acc[k].y; }
        LDS_BARRIER();
        { const int pair = F.tid >> 3, oct = F.tid & 7; float s = 0.f;
#pragma unroll
          for (int k = 0; k < 32; ++k) s += red[(pair * 8 + oct) * 33 + k];
          s += __shfl_xor(s, 1); s += __shfl_xor(s, 2); s += __shfl_xor(s, 4);
          LDS_BARRIER();
          if (oct == 0) red[pair] = s; }
        LDS_BARRIER();
        if (F.tid < 32) { const int h2 = F.tid >> 4, k = F.tid & 15; const float mean = red[h2 * 32 + k] * (1.f / DCONV), ex2 = red[h2 * 32 + 16 + k] * (1.f / DCONV);
            stat[F.tid] = (f32x2){mean, __builtin_amdgcn_rsqf(fmaxf(ex2 - mean * mean, 0.f) + LN_EPS)}; }
        LDS_BARRIER();
#pragma unroll
        for (int k = 0; k < 16; ++k) { const f32x2 st = stat[hb * 16 + k];
            const float a = (acc[k].x - st.x) * st.y * lg.x + lb.x, b = (acc[k].y - st.x) * st.y * lg.y + lb.y;
            *(unsigned*)(Cat + (size_t)(row0 + k) * DM + DSSM + c0) = cvt_pk_bf16(a * sigmoidf_(a), b * sigmoidf_(b)); }
    }
#undef CONV_LOAD
    __syncthreads();
}


__device__ __forceinline__ void colsum_finalize(const Params& p, const Frame& F0) {
    const Frame F = fresh(F0);
    const float* csp = (const float*)(p.ws + WS_CSP); float* csf = (float*)(p.ws + WS_CSF);
    for (int i = F.vcu * 512 + F.tid; i < 2 * DM + 2 * DFF; i += F.G * 512) {
        const float* src; int N, n; float add = 0.f;
        if (i < DM) { src = csp; N = DM; n = i; } else if (i < 2 * DM) { src = csp + 16 * DM; N = DM; n = i - DM; }
        else if (i < 2 * DM + DFF) { src = csp + 32 * DM; N = DFF; n = i - 2 * DM; } else { src = csp + 32 * DM + 16 * DFF; N = DFF; n = i - 2 * DM - DFF; add = p.in[33][n]; }
        float s = 0.f;
#pragma unroll
        for (int kb = 0; kb < 16; ++kb) s += src[(size_t)kb * N + n];
        csf[i] = s + add;
    }
}

__device__ __forceinline__ void ln_bf16_phase(const Frame& F0, const bf16_t* T, bf16_t* X, const float* gam, const float* bet) {
    const Frame F = fresh(F0);
    const int gw = F.vcu * 8 + F.wave, NGW = F.G * 8;
    f32x4 g4[4], b4[4];
#pragma unroll
    for (int h = 0; h < 2; ++h) { g4[2 * h] = *(const f32x4*)(gam + h * 512 + F.lane * 8); g4[2 * h + 1] = *(const f32x4*)(gam + h * 512 + F.lane * 8 + 4);
        b4[2 * h] = *(const f32x4*)(bet + h * 512 + F.lane * 8); b4[2 * h + 1] = *(const f32x4*)(bet + h * 512 + F.lane * 8 + 4); }
    for (int m = gw; m < R; m += NGW) {
        f32x4 v[4]; float s = 0.f;
#pragma unroll
        for (int h = 0; h < 2; ++h) { pg8::unpack8(*(const u32x4*)(T + (size_t)m * DM + h * 512 + F.lane * 8), v[2 * h], v[2 * h + 1]); }
#pragma unroll
        for (int q = 0; q < 4; ++q) s += (v[q][0] + v[q][1]) + (v[q][2] + v[q][3]);
        const float mean = wave_sum(s) * (1.f / DM); float s2 = 0.f;
#pragma unroll
        for (int q = 0; q < 4; ++q) { v[q] = v[q] - mean; s2 += (v[q][0] * v[q][0] + v[q][1] * v[q][1]) + (v[q][2] * v[q][2] + v[q][3] * v[q][3]); }
        const float rstd = __builtin_amdgcn_rsqf(wave_sum(s2) * (1.f / DM) + LN_EPS);
#pragma unroll
        for (int h = 0; h < 2; ++h) *(u32x4*)(X + (size_t)m * DM + h * 512 + F.lane * 8) = pg8::pack8(v[2 * h] * rstd * g4[2 * h] + b4[2 * h], v[2 * h + 1] * rstd * g4[2 * h + 1] + b4[2 * h + 1]);
    }
}
__device__ __forceinline__ void ln_f32_inplace_phase(const Frame& F0, float* Y, const float* gam, const float* bet) {
    const Frame F = fresh(F0);
    const int gw = F.vcu * 8 + F.wave, NGW = F.G * 8;
    f32x4 g4[4], b4[4];
#pragma unroll
    for (int q = 0; q < 4; ++q) { g4[q] = *(const f32x4*)(gam + q * 256 + F.lane * 4); b4[q] = *(const f32x4*)(bet + q * 256 + F.lane * 4); }
    const bool xl = (F.G == 256);
    const int xx = gw >> 8, wv = gw & 255, nit = xl ? 9 : (R + 2 * NGW - 1) / (2 * NGW);
    for (int it = 0; it < nit; ++it) {
        int m0, m1; bool ok0, ok1;
        if (xl) { const int k0 = 2 * it, k1 = k0 + 1;
            m0 = (k0 < 16) ? 256 * (16 * xx + (k0 < 8 ? 8 + k0 : k0 - 8)) + wv : NP + 32 * xx + wv; ok0 = (k0 < 16) || (wv < 32);
            m1 = 256 * (16 * xx + (k1 < 8 ? 8 + k1 : k1 - 8)) + wv; ok1 = k1 < 16; }
        else { m0 = gw + it * 2 * NGW; m1 = m0 + NGW; ok0 = m0 < R; ok1 = m1 < R; }
        const int mm0 = ok0 ? m0 : 0, mm1 = ok1 ? m1 : mm0;
        f32x4 v[2][4];
#pragma unroll
        for (int q = 0; q < 4; ++q) { v[0][q] = *(const f32x4*)(Y + (size_t)mm0 * DM + q * 256 + F.lane * 4); v[1][q] = *(const f32x4*)(Y + (size_t)mm1 * DM + q * 256 + F.lane * 4); }
#pragma unroll
        for (int h = 0; h < 2; ++h) {
            float s = 0.f;
#pragma unroll
            for (int q = 0; q < 4; ++q) s += (v[h][q][0] + v[h][q][1]) + (v[h][q][2] + v[h][q][3]);
            const float mean = wave_sum(s) * (1.f / DM); float s2 = 0.f;
#pragma unroll
            for (int q = 0; q < 4; ++q) { v[h][q] = v[h][q] - mean; s2 += (v[h][q][0] * v[h][q][0] + v[h][q][1] * v[h][q][1]) + (v[h][q][2] * v[h][q][2] + v[h][q][3] * v[h][q][3]); }
            const float rstd = __builtin_amdgcn_rsqf(wave_sum(s2) * (1.f / DM) + LN_EPS);
            if (h == 0 ? ok0 : ok1) {
                float* yo = Y + (size_t)(h == 0 ? m0 : m1) * DM;
#pragma unroll
                for (int q = 0; q < 4; ++q) __builtin_nontemporal_store(v[h][q] * rstd * g4[q] + b4[q], (f32x4*)(yo + q * 256 + F.lane * 4));
            }
        }
    }
}

#define XB_TMO      128
#define XB_XCNT(j)  (256  + 64 * (j))
#define XB_XSUB(j)  (1280 + 64 * (j))
#define XB_XGEN(j)  (2304 + 64 * (j))
#define XB_TOP      3328
#define XB_TOPGEN   3392
#define XCD_BAR_WORDS 3456
#define XB_SPIN_CAP (1u << 18)
__device__ __forceinline__ unsigned xb_ld(unsigned* p)              { return __hip_atomic_load(p, __ATOMIC_RELAXED, __HIP_MEMORY_SCOPE_AGENT); }
__device__ __forceinline__ unsigned xb_add(unsigned* p, unsigned v) { return __hip_atomic_fetch_add(p, v, __ATOMIC_RELAXED, __HIP_MEMORY_SCOPE_AGENT); }
__device__ __forceinline__ unsigned xb_xcc_id() { return (unsigned)__builtin_amdgcn_s_getreg((3 << 11) | 20) & 0xFu; }
#define XB_SPIN(cond, bar) do { unsigned _sp = 0; while (cond) { __builtin_amdgcn_s_sleep(1); \
    if ((++_sp & 255u) == 0u) { if (xb_ld(&(bar)[XB_TMO])) break; if (_sp > XB_SPIN_CAP) { atomicAdd(&(bar)[XB_TMO], 1u); break; } } } } while (0)
struct XcdBarrier { unsigned* bar; unsigned x; volatile LAS unsigned* st; };
__device__ __forceinline__ XcdBarrier xcd_barrier_post(unsigned* bar, volatile LAS unsigned* st) {
    XcdBarrier b; b.bar = bar; b.x = xb_xcc_id(); b.st = st;
    if (threadIdx.x == 0) (void)xb_add(&bar[XB_XCNT(b.x)], 1u);
    return b;
}
__device__ __forceinline__ void xcd_barrier_complete(unsigned* bar, unsigned x, unsigned& nloc, unsigned& nx) {
    const unsigned G = gridDim.x * gridDim.y * gridDim.z;
    unsigned sum, cnt, mine, sp = 0u;
    for (;;) {
        sum = 0u; cnt = 0u; mine = 0u;
#pragma unroll
        for (unsigned j = 0; j < 16; ++j) { const unsigned c = xb_ld(&bar[XB_XCNT(j)]); sum += c; cnt += (c > 0u) ? 1u : 0u; mine = (j == x) ? c : mine; }
        if (sum == G) break;
        __builtin_amdgcn_s_sleep(1);
        if ((++sp & 255u) == 0u) { if (xb_ld(&bar[XB_TMO])) break; if (sp > XB_SPIN_CAP) { atomicAdd(&bar[XB_TMO], 1u); break; } }
    }
    nloc = mine > 0u ? mine : 1u; nx = cnt > 0u ? cnt : 1u;
}
__device__ __forceinline__ void xcd_barrier(const XcdBarrier& b) {
    asm volatile("s_waitcnt vmcnt(0)" ::: "memory");
    __syncthreads();
    if (threadIdx.x == 0) {
        unsigned* bar = b.bar;
        __builtin_amdgcn_s_waitcnt(0);
        unsigned nloc = b.st[0], nx = b.st[1];
        if (nloc == 0u) { xcd_barrier_complete(bar, b.x, nloc, nx); b.st[0] = nloc; b.st[1] = nx; }
        const unsigned old = xb_add(&bar[XB_XSUB(b.x)], 1u);
        const unsigned gen = old / nloc;
        if (old + 1u == (gen + 1u) * nloc) {
            __builtin_amdgcn_fence(__ATOMIC_RELEASE, "agent");
            asm volatile("s_waitcnt vmcnt(0)" ::: "memory");
            const unsigned og = xb_add(&bar[XB_TOP], 1u);
            const unsigned tg = og / nx;
            if (og + 1u == (tg + 1u) * nx) xb_add(&bar[XB_TOPGEN], 1u);
            else XB_SPIN(xb_ld(&bar[XB_TOPGEN]) == tg, bar);
            __builtin_amdgcn_fence(__ATOMIC_ACQUIRE, "agent");
            xb_add(&bar[XB_XGEN(b.x)], 1u);
            asm volatile("s_waitcnt vmcnt(0)" ::: "memory");
        } else {
            XB_SPIN(xb_ld(&bar[XB_XGEN(b.x)]) == gen, bar);
            __builtin_amdgcn_fence(__ATOMIC_ACQUIRE, "agent");
            asm volatile("s_waitcnt vmcnt(0)" ::: "memory");
        }
    }
    __syncthreads();
}

__global__ void __launch_bounds__(512, 2) fwd_megakernel(Params p) {
    extern __shared__ __attribute__((aligned(16))) unsigned char lds_raw[];
    cg::grid_group grid = cg::this_grid();
    Frame F; F.lds = (LAS unsigned char*)lds_raw; F.tid = threadIdx.x; F.lane = F.tid & 63; F.wave = __builtin_amdgcn_readfirstlane(F.tid >> 6);
    F.G = gridDim.x; { const int bx = blockIdx.x; F.vcu = (F.G % 8 == 0) ? (bx % 8) * (F.G / 8) + bx / 8 : bx; }
    const int c = blockIdx.x, G = F.G;
    unsigned char* ws = p.ws;
    bf16_t* Xb = (bf16_t*)(ws + WS_XB); bf16_t* Ub = (bf16_t*)(ws + WS_UB); bf16_t* Vb = (bf16_t*)(ws + WS_VB); bf16_t* Zb = (bf16_t*)(ws + WS_ZB); bf16_t* Cat = (bf16_t*)(ws + WS_CAT);
    bf16_t* T1 = (bf16_t*)(ws + WS_T1); f32x2* ST1 = (f32x2*)(ws + WS_ST1); f32x2* ST2 = (f32x2*)(ws + WS_ST2); const float* CSF = (const float*)(ws + WS_CSF); bf16_t* Qb = (bf16_t*)(ws + WS_QB); bf16_t* Pb = (bf16_t*)(ws + WS_PB); bf16_t* Ob = (bf16_t*)(ws + WS_OB);
    bf16_t* T2 = (bf16_t*)(ws + WS_T2); bf16_t* Hb = (bf16_t*)(ws + WS_HB);
    bf16_t* Kb = (bf16_t*)(ws + WS_KB); bf16_t* Vt = (bf16_t*)(ws + WS_VT); bf16_t* Mb = (bf16_t*)(ws + WS_MEMB);
    using namespace pg8;
    { volatile LAS unsigned* st0 = (volatile LAS unsigned*)(F.lds + RING_BYTES + 12288); if (F.tid < 4) st0[F.tid] = 0u; }
    __syncthreads();
    const XcdBarrier xbar = xcd_barrier_post((unsigned*)ws, (volatile LAS unsigned*)(F.lds + RING_BYTES + 12288));
#define GRID_BAR() xcd_barrier(xbar)

    if constexpr (PHASE_MASK & 1) p0_prologue(p, F);
    if constexpr (PROBE_DUP & 1) p0_prologue(p, F);
    if (p.ws == nullptr) grid.sync();
    GRID_BAR();
    for (int rep = 0; rep < ((PROBE_DUP & 2048) ? 2 : 1); ++rep)
    if constexpr (PHASE_MASK & 2) { const bf16_t* Win_t = (const bf16_t*)(ws + WS_WIN); const bf16_t* Wkv_t = (const bf16_t*)(ws + WS_WKV);
      RegSched S; S.init(Xb, DM, Win_t, DM, NP, DIN, G, c); EpiWin E{Ub, Vb, p.out};
      gemm_phase<EpiWin, RegSched, true>(F.lds, GemmDesc{DM, DM, DM}, S, E);
      small_gemm<EpiWin, false>(F.lds, Xb + (size_t)NP * DM, DM, Win_t, DM, DM, 4, 8, NP, 0, E, G, c);
      small_gemm<EpiWin, true>(F.lds, Xb + (size_t)NP * DM, DM, Win_t, DM, DM, 4, 16, NP, 0, E, G, (c + G - 32) % G);
      { EpiKv E2{Kb, Vt, p.out, 0, nullptr}; small_gemm<EpiKv, false>(F.lds, Mb, DM, Wkv_t, DM, DM, 8, 16, 0, 0, E2, G, (c + G - 96) % G); }
      { EpiKv E2{Kb, Vt, p.out, 1, (bf16_t*)(ws + WS_V16)}; small_gemm<EpiKv, false>(F.lds, Mb, DM, Wkv_t + (size_t)DM * DM, DM, DM, 8, 16, 0, 0, E2, G, (c + G - 224) % G); }
        }
    GRID_BAR();
    colsum_finalize(p, F);
    if constexpr (PHASE_MASK & 4) ssm_phase<false>(p, F);
    if constexpr (PHASE_MASK & 8) conv_phase<0>(p, F);
    {
        const bf16_t* Wo_t = (const bf16_t*)(ws + WS_WO); const bf16_t* V16 = (const bf16_t*)(ws + WS_V16); bf16_t* NT = (bf16_t*)(ws + WS_NT);
#pragma unroll 1
        for (int q = 0; q < 8; ++q) { const int b = q >> 2, h = q & 3;
            EpiGen<0> E{NT + (size_t)b * DM * DM, DM, nullptr, 0, nullptr, 1.f};
            small_gemm<EpiGen<0>, false>(F.lds, Wo_t + h * 256, DM, V16 + (size_t)(b * NMEM) * DM + h * 256, DM, HD, 16, 4, 0, h * 256, E, G, (c + G - (64 * q) % G) % G); }
    }
    if constexpr (PROBE_DUP & 2) ssm_phase<false>(p, F);
    if constexpr (PROBE_DUP & 4) conv_phase<0>(p, F);
    if constexpr (PROBE_DUP & 32) conv_phase<1>(p, F);
    if constexpr (PROBE_DUP & 64) conv_phase<2>(p, F);
    GRID_BAR();
    if constexpr (PHASE_MASK & 16) ssm_phase<true>(p, F);
    if constexpr (PROBE_DUP & 8) ssm_phase<true>(p, F);
    GRID_BAR();
    if constexpr (PHASE_MASK & 32) { RegSched S; S.init(Zb, DSSM, (const bf16_t*)(ws + WS_GLU), DSSM, NP, DSSM, G, c); EpiGen<4> E{Cat, DM, Zb, DSSM, p.in[18], 1.f};
      gemm_phase<EpiGen<4>, RegSched, true>(F.lds, GemmDesc{DSSM, DSSM, DSSM}, S, E);
      small_gemm<EpiGen<4>, false>(F.lds, Zb + (size_t)NP * DSSM, DSSM, (const bf16_t*)(ws + WS_GLU), DSSM, DSSM, 4, 8, NP, 0, E, G, c); }
    GRID_BAR();
    if constexpr (PHASE_MASK & 64) { RegSched S; S.init(Cat, DM, (const bf16_t*)(ws + WS_WOUT), DM, NP, DM, G, c); EpiLn<1> E{T1, DM, Xb, nullptr, ST1, nullptr, nullptr, nullptr, 1.f, 0};
      gemm_phase<EpiLn<1>, RegSched, true>(F.lds, GemmDesc{DM, DM, DM}, S, E);
      small_gemm<EpiLn<1>, false>(F.lds, Cat + (size_t)NP * DM, DM, (const bf16_t*)(ws + WS_WOUT), DM, DM, 4, 16, NP, 0, E, G, c); }
    GRID_BAR();
    if constexpr (PHASE_MASK & 256) { RegSched S; S.init(T1, DM, (const bf16_t*)(ws + WS_WQ), DM, NP, DM, G, c); EpiLn<2> E{Qb, DM, nullptr, ST1, nullptr, CSF, CSF + DM, nullptr, 0.0625f, 0}; E.prep(S, F.lds + RING_BYTES);
      gemm_phase<EpiLn<2>, RegSched, true>(F.lds, GemmDesc{DM, DM, DM}, S, E);
      small_gemm<EpiLn<2>, false>(F.lds, T1 + (size_t)NP * DM, DM, (const bf16_t*)(ws + WS_WQ), DM, DM, 4, 16, NP, 0, E, G, c); }
    GRID_BAR();
    for (int rep = 0; rep < ((PROBE_DUP & 1024) ? 2 : 1); ++rep)
    if constexpr (PHASE_MASK & 512) { AttSched S{Qb, Kb, 0, G, c, 0}; EpiSoftmax E{Pb};
      gemm_phase<EpiSoftmax, AttSched, true>(F.lds, GemmDesc{HD, DM, DM}, S, E); }
    asm volatile("s_waitcnt vmcnt(0)" ::: "memory"); __syncthreads();
    if (F.tid == 0) { __builtin_amdgcn_fence(__ATOMIC_ACQUIRE, "agent"); asm volatile("s_waitcnt vmcnt(0)" ::: "memory"); }
    __syncthreads();
    if constexpr (PHASE_MASK & 1024) { AttSched S{Pb, Vt, 1, G, c, 512}; EpiGen<0> E{Ob, DM, nullptr, 0, nullptr, 1.f};
      gemm_phase<EpiGen<0>, AttSched, true>(F.lds, GemmDesc{NMEM, DM, NMEM}, S, E); }
    GRID_BAR();
    if constexpr (PHASE_MASK & 2048) { BatchSched S; S.init(Pb, DM, (const bf16_t*)(ws + WS_NT), DM, NP, DM, G, c); EpiLn<3> E{T2, DM, T1, ST1, ST2, p.in[24], p.in[25], nullptr, 1.f, 0}; E.prep(S, F.lds + RING_BYTES);
      gemm_phase<EpiLn<3>, BatchSched, true>(F.lds, GemmDesc{DM, DM, DM}, S, E);
      small_gemm<EpiLn<3>, false>(F.lds, Ob + (size_t)NP * DM, DM, (const bf16_t*)(ws + WS_WO), DM, DM, 4, 16, NP, 0, E, G, c); }
    GRID_BAR();
    if constexpr (PHASE_MASK & 4096) { RegSched S; S.init(T2, DM, (const bf16_t*)(ws + WS_W1), DM, NP, DFF, G, c); EpiLn<4> E{Hb, DFF, nullptr, ST2, nullptr, CSF + 2 * DM, CSF + 2 * DM + DFF, nullptr, 1.f, 0}; E.prep(S, F.lds + RING_BYTES);
      gemm_phase<EpiLn<4>, RegSched, true>(F.lds, GemmDesc{DM, DM, DM}, S, E);
      small_gemm<EpiLn<4>, false>(F.lds, T2 + (size_t)NP * DM, DM, (const bf16_t*)(ws + WS_W1), DM, DM, 4, 64, NP, 0, E, G, c); }
    GRID_BAR();
    if constexpr (PHASE_MASK & 8192) { RegSched S; S.init(Hb, DFF, (const bf16_t*)(ws + WS_W2), DFF, NP, DM, G, c); EpiLn<5> E{p.out, DM, T2, ST2, nullptr, p.in[30], p.in[31], p.in[35], 1.f, 0}; E.prep(S, F.lds + RING_BYTES);
      gemm_phase<EpiLn<5>, RegSched, true>(F.lds, GemmDesc{DFF, DFF, DFF}, S, E);
      small_gemm<EpiLn<5>, false>(F.lds, Hb + (size_t)NP * DFF, DFF, (const bf16_t*)(ws + WS_W2), DFF, DFF, 4, 16, NP, 0, E, G, c); }
    GRID_BAR();
    if constexpr (PROBE_DUP & 4096) { GRID_BAR(); GRID_BAR(); GRID_BAR(); GRID_BAR(); }
    if constexpr (PHASE_MASK & 16384) ln_f32_inplace_phase(F, p.out, p.in[36], p.in[37]);
}

extern "C" void kernel_launch(void* const* d_in, const int* in_sizes, int n_in, void* d_out, int out_size, void* d_ws, size_t ws_size, hipStream_t stream) {
    static int grid = 0;
    if (grid == 0) {
        if (n_in != 38 || ws_size < WS_END) { fprintf(stderr, "kernel_launch: unexpected n_in %d / ws_size %zu (need %zu)\n", n_in, ws_size, (size_t)WS_END); grid = -1; return; }
        int dev = 0, cus = 0, per_cu = 0;
        hipGetDevice(&dev); hipDeviceGetAttribute(&cus, hipDeviceAttributeMultiprocessorCount, dev);
        hipFuncSetAttribute((const void*)fwd_megakernel, hipFuncAttributeMaxDynamicSharedMemorySize, LDS_BYTES);
        hipOccupancyMaxActiveBlocksPerMultiprocessor(&per_cu, (const void*)fwd_megakernel, 512, LDS_BYTES);
        if (per_cu < 1) { fprintf(stderr, "kernel_launch: occupancy query says %d blocks per CU\n", per_cu); per_cu = 1; }
        grid = cus;
        if (grid > 256) grid = 256;
    }
    if (grid < 0) return;
    Params p{};
    for (int i = 0; i < 38; ++i) p.in[i] = (const float*)d_in[i];
    p.out = (float*)d_out; p.ws = (unsigned char*)d_ws;
    hipMemsetAsync(d_ws, 0, 16384, stream);
    void* args[] = {&p};
    hipError_t e = hipLaunchCooperativeKernel((const void*)fwd_megakernel, dim3(grid), dim3(512), args, LDS_BYTES, stream);
    if (e != hipSuccess) fprintf(stderr, "cooperative launch failed: %s (grid %d)\n", hipGetErrorString(e), grid);
}
```

```cpp
#include <hip/hip_runtime.h>
#include <hip/hip_cooperative_groups.h>
#include <cstdio>
#include <cstdint>
namespace cg = cooperative_groups;

#define LAS __attribute__((address_space(3)))
typedef unsigned short bf16_t;
typedef short bf16x8 __attribute__((ext_vector_type(8)));
typedef float f32x4 __attribute__((ext_vector_type(4)));
typedef float f32x2 __attribute__((ext_vector_type(2)));
typedef unsigned u32x4 __attribute__((ext_vector_type(4)));
typedef unsigned u32x2 __attribute__((ext_vector_type(2)));
typedef __bf16 bf16v2 __attribute__((ext_vector_type(2)));

constexpr int DM = 1024, SEQ = 16384, NB = 2, NP = NB * SEQ, NSB = 16, NST = 16, NS = NSB * NST, R = NP + NS, RPAD = R + 256;
constexpr int DSSM = 512, DCONV = 512, DIN = 1536, DFF = 4096, NMEM = 256, NH = 4, HD = 256, NG = 32, NSTATE = 64, CW = 31;
constexpr float ALPHA = 1.189207115002721f;
constexpr float LN_EPS = 1e-5f;
constexpr size_t O_Y = 0, O_SRP = (size_t)R * DM, O_SIP = O_SRP + 4096, O_CVP = O_SIP + 4096, O_MKP = O_CVP + 30720, O_MVP = O_MKP + 524288,
                 O_SRS = O_MVP + 524288, O_SIS = O_SRS + 32768, O_CVS = O_SIS + 32768;
constexpr size_t MiB = 1u << 20;
constexpr size_t WS_WIN = 1 * MiB, WS_GLU = 4 * MiB, WS_WOUT = 5 * MiB, WS_WQ = 7 * MiB, WS_WKV = 9 * MiB, WS_WO = 13 * MiB, WS_W1 = 15 * MiB, WS_W2 = 23 * MiB,
                 WS_SSMW = 460 * MiB  , WS_M1 = 33 * MiB  , WS_WST = 34 * MiB  , WS_MEMB = 35 * MiB  ,
                 WS_KB = 36 * MiB  , WS_VT = 45 * MiB  ;
constexpr size_t WS_S1 = 56 * MiB, WS_S2 = 122 * MiB, WS_BIG = 188 * MiB;
constexpr size_t WS_T1 = WS_S1, WS_T2 = WS_S2;
constexpr size_t WS_CSP = 54 * MiB  , WS_CSF = 55 * MiB  ;
constexpr size_t WS_ST1 = 448 * MiB, WS_ST2 = 453 * MiB;
constexpr size_t WS_XB = WS_BIG, WS_UB = WS_BIG + 66 * MiB, WS_VB = WS_BIG + 99 * MiB, WS_ZB = WS_BIG + 132 * MiB, WS_CAT = WS_BIG + 165 * MiB;
constexpr size_t WS_QB = WS_BIG, WS_PB = WS_BIG + 66 * MiB, WS_OB = WS_BIG + 132 * MiB, WS_HB = WS_BIG;
constexpr size_t WS_V16 = 464 * MiB  , WS_NT = 465 * MiB  ;
constexpr size_t WS_END = 470 * MiB;
constexpr int SSM_NFRAG = 96, SSM_FRAG_ELEMS = SSM_NFRAG * 512;
constexpr int SSM_M1_OFF = SSM_FRAG_ELEMS * 2;

#ifndef PROBE_DUP
#define PROBE_DUP 0
#endif
#ifndef PHASE_MASK
#define PHASE_MASK 0xFFFF
#endif
constexpr int LDS_BYTES = 147456;
constexpr int RING_BYTES = 131072;

struct Params {
    const float* in[38];
    float* out;
    unsigned char* ws;
};

__device__ __forceinline__ unsigned cvt_pk_bf16(float lo, float hi) { unsigned r; asm("v_cvt_pk_bf16_f32 %0, %1, %2" : "=v"(r) : "v"(lo), "v"(hi)); return r; }
__device__ __forceinline__ float bf_lo(unsigned w) { return __uint_as_float(w << 16); }
__device__ __forceinline__ float bf_hi(unsigned w) { return __uint_as_float(w & 0xffff0000u); }
__device__ __forceinline__ unsigned short f2bf(float f) { return (unsigned short)(cvt_pk_bf16(f, 0.f) & 0xffffu); }
__device__ __forceinline__ float sigmoidf_(float x) { return __builtin_amdgcn_rcpf(1.f + __builtin_amdgcn_exp2f(-1.4426950408889634f * x)); }
__device__ __forceinline__ float gelu_tanh(float x) {
    const float t = x * x, u = x * (-2.3022082f - 0.10294324f * t); return x * __builtin_amdgcn_rcpf(1.f + __builtin_amdgcn_exp2f(u)); }
template <int CTRL> __device__ __forceinline__ float dppf(float v) {
    return __builtin_bit_cast(float, __builtin_amdgcn_update_dpp(0, __builtin_bit_cast(int, v), CTRL, 0xf, 0xf, true));
}
#define DPP_SHR(n) (0x110 + (n))
#define DPP_ROR(n) (0x120 + (n))
#define LDS_BARRIER() do { asm volatile("s_waitcnt lgkmcnt(0)" ::: "memory"); __builtin_amdgcn_s_barrier(); asm volatile("" ::: "memory"); } while (0)
__device__ __forceinline__ float wave_sum(float v) {
#pragma unroll
    for (int o = 1; o < 64; o <<= 1) v += __shfl_xor(v, o);
    return v;
}

namespace pg8 {
constexpr int BM = 256, BK = 64, HALF = 128, HTB = HALF * BK * 2, STAGE_BYTES = 8 * HTB;
__host__ __device__ __forceinline__ int lds_byte(int r, int c) { const int st = (r >> 4) * 2 + (c >> 5), rr = r & 15, cc = c & 31, ob = rr * 64 + cc * 2; return st * 1024 + (ob ^ (((ob >> 9) & 1) << 5)); }
__host__ __device__ __forceinline__ void stage_rc(int b, int& Rr, int& C) { const int st = b / 1024, sb = b % 1024, swz = sb ^ (((sb >> 9) & 1) << 5); Rr = (st >> 1) * 16 + swz / 64; C = (st & 1) * 32 + (swz % 64) / 2; }
__host__ __device__ __forceinline__ int perm32(int rho) { const int n = rho >> 4, i = rho & 15; return 8 * (i >> 2) + 4 * n + (i & 3); }

struct Unit { int row0, col0, nvalid, aux; };
struct GemmDesc { int K, lda, ldb; };

template <class Epi, class Sched, bool ALIGN_EPI>
__device__ __forceinline__ void gemm_phase(LAS unsigned char* lds, const GemmDesc g, const Sched& S, const Epi& E) {
    int tid = threadIdx.x; asm volatile("" : "+v"(tid));
    const int wid = __builtin_amdgcn_readfirstlane(tid >> 6), lane = tid & 63, wr = wid >> 2, wc = wid & 3, fr = lane & 15, fq = lane >> 4;
    const int K = g.K, nt = K / BK;
    unsigned voffA[2], voffB[2];
#pragma unroll
    for (int i = 0; i < 2; ++i) { int Rr, C; stage_rc(tid * 16 + i * 8192, Rr, C); const int Rb = Epi::PERM ? ((Rr & ~31) + perm32(Rr & 31)) : Rr;
        voffA[i] = (unsigned)(Rr * g.lda + C) * 2u; voffB[i] = (unsigned)(Rb * g.ldb + C) * 2u; }
    const size_t kstep = (size_t)(BK * 2);
    const size_t hstepA = (size_t)HALF * g.lda * 2, hstepB = (size_t)HALF * g.ldb * 2;
    const unsigned ldsw = (unsigned)wid * 1024u;
    const int aoff = lds_byte(wr * 64 + fr, fq * 8), boff = lds_byte(wc * 32 + fr, fq * 8);
#define PG8_SA(b, h) (((b) * 2 + (h)) * HTB)
#define PG8_SB(b, h) ((4 + (b) * 2 + (h)) * HTB)
#define PG8_STAGE(bufoff, gbase, voff) do { _Pragma("unroll") for (int _i = 0; _i < 2; ++_i) \
        __builtin_amdgcn_global_load_lds((const unsigned*)((const char*)(gbase) + (voff)[_i]), (LAS unsigned*)(lds + (bufoff) + ldsw + _i * 8192), 16, 0, 0); } while (0)
#define PG8_LDA(dst, b, h) do { _Pragma("unroll") for (int m = 0; m < 4; ++m) _Pragma("unroll") for (int k = 0; k < 2; ++k) dst[m][k] = *(const LAS bf16x8*)(lds + PG8_SA(b, h) + aoff + m * 2048 + k * 1024); } while (0)
#define PG8_LDB(dst, b, h) do { _Pragma("unroll") for (int n = 0; n < 2; ++n) _Pragma("unroll") for (int k = 0; k < 2; ++k) dst[n][k] = *(const LAS bf16x8*)(lds + PG8_SB(b, h) + boff + n * 2048 + k * 1024); } while (0)
#define PG8_MMA(ai, bj, At, Bt) do { __builtin_amdgcn_s_setprio(1); _Pragma("unroll") for (int m = 0; m < 4; ++m) _Pragma("unroll") for (int n = 0; n < 2; ++n) _Pragma("unroll") for (int k = 0; k < 2; ++k) \
        acc[ai][bj][m][n] = __builtin_amdgcn_mfma_f32_16x16x32_bf16(Bt[n][k], At[m][k], acc[ai][bj][m][n], 0, 0, 0); __builtin_amdgcn_s_setprio(0); } while (0)
#define PG8_WAIT_V(n) asm volatile("s_waitcnt vmcnt(" #n ")" ::: "memory")
#define PG8_WAIT_L(n) asm volatile("s_waitcnt lgkmcnt(" #n ")" ::: "memory")
#define PG8_BAR __builtin_amdgcn_s_barrier()
#define PG8_SCHED __builtin_amdgcn_sched_barrier(0)
    Unit cur, nxt; int ui = 0;
    if (!S.next(0, cur)) return;
    f32x4 acc[2][2][4][2];
#pragma unroll
    for (int a = 0; a < 2; ++a)
#pragma unroll
        for (int b = 0; b < 2; ++b)
#pragma unroll
            for (int m = 0; m < 4; ++m)
#pragma unroll
                for (int n = 0; n < 2; ++n) acc[a][b][m][n] = (f32x4){0.f, 0.f, 0.f, 0.f};
    bf16x8 At[4][2], B0[2][2], B1[2][2];
    const char* cA = S.aptr(cur); const char* cB = S.bptr(cur);
    PG8_STAGE(PG8_SB(0, 0), cB, voffB); PG8_STAGE(PG8_SB(0, 1), cB + hstepB, voffB); PG8_STAGE(PG8_SA(0, 0), cA, voffA); PG8_STAGE(PG8_SA(0, 1), cA + hstepA, voffA);
    if (wr == 1) PG8_BAR;
    PG8_WAIT_V(2); PG8_BAR;
    PG8_STAGE(PG8_SB(1, 0), cB + kstep, voffB); PG8_STAGE(PG8_SA(1, 0), cA + kstep, voffA); PG8_STAGE(PG8_SB(1, 1), cB + hstepB + kstep, voffB);
    PG8_WAIT_V(6); PG8_BAR;
    for (;;) {
        const bool has_next = S.next(ui + 1, nxt);
        const char* nA = has_next ? S.aptr(nxt) : cA; const char* nB = has_next ? S.bptr(nxt) : cB;
        for (int t = 0; t < nt; t += 2) {
            const bool last = (t == nt - 2);
            const char* a1 = cA + (size_t)(t + 1) * kstep;
            const char* a2 = last ? nA : cA + (size_t)(t + 2) * kstep; const char* b2 = last ? nB : cB + (size_t)(t + 2) * kstep;
            const char* a3 = a2 + kstep; const char* b3 = b2 + kstep;
            PG8_LDB(B0, 0, 0); PG8_LDB(B1, 0, 1); PG8_SCHED; PG8_LDA(At, 0, 0); PG8_STAGE(PG8_SA(1, 1), a1 + hstepA, voffA);
            PG8_WAIT_V(8); PG8_WAIT_L(0); PG8_BAR; PG8_MMA(0, 0, At, B0); PG8_MMA(0, 1, At, B1); PG8_BAR; PG8_SCHED;
            PG8_LDA(At, 0, 1); PG8_STAGE(PG8_SB(0, 0), b2, voffB); PG8_STAGE(PG8_SB(0, 1), b2 + hstepB, voffB); PG8_STAGE(PG8_SA(0, 0), a2, voffA);
            PG8_WAIT_V(8); PG8_WAIT_L(0); PG8_BAR; PG8_MMA(1, 0, At, B0); PG8_MMA(1, 1, At, B1); PG8_BAR; PG8_SCHED;
            PG8_LDB(B0, 1, 0); PG8_LDB(B1, 1, 1); PG8_SCHED; PG8_LDA(At, 1, 0); PG8_STAGE(PG8_SA(0, 1), a2 + hstepA, voffA);
            PG8_WAIT_V(8); PG8_WAIT_L(0); PG8_BAR; PG8_MMA(0, 0, At, B0); PG8_MMA(0, 1, At, B1); PG8_BAR; PG8_SCHED;
            PG8_LDA(At, 1, 1); PG8_STAGE(PG8_SB(1, 0), b3, voffB); PG8_STAGE(PG8_SB(1, 1), b3 + hstepB, voffB); PG8_STAGE(PG8_SA(1, 0), a3, voffA);
            PG8_WAIT_V(8); PG8_WAIT_L(0); PG8_BAR; PG8_MMA(1, 0, At, B0); PG8_MMA(1, 1, At, B1); PG8_BAR; PG8_SCHED;
        }
        if constexpr (ALIGN_EPI) { if (wr == 0) PG8_BAR; }
        E(acc, cur, wr, wc, fr, fq, lds + STAGE_BYTES);
        if (!has_next) break;
#pragma unroll
        for (int a = 0; a < 2; ++a)
#pragma unroll
            for (int b = 0; b < 2; ++b)
#pragma unroll
                for (int m = 0; m < 4; ++m)
#pragma unroll
                    for (int n = 0; n < 2; ++n) acc[a][b][m][n] = (f32x4){0.f, 0.f, 0.f, 0.f};
        cur = nxt; cA = nA; cB = nB; ++ui;
        if constexpr (ALIGN_EPI) { if (wr == 1) PG8_BAR; }
    }
    PG8_WAIT_V(0);
    if constexpr (!ALIGN_EPI) { if (wr == 0) PG8_BAR; }
    PG8_BAR;
#undef PG8_SA
#undef PG8_SB
#undef PG8_STAGE
#undef PG8_LDA
#undef PG8_LDB
#undef PG8_MMA
#undef PG8_WAIT_V
#undef PG8_WAIT_L
#undef PG8_BAR
#undef PG8_SCHED
}

struct RegSched {
    const bf16_t* A; const bf16_t* B; int lda, ldb, nM, nN, nwg, G, c;
    __device__ void init(const bf16_t* A_, int lda_, const bf16_t* B_, int ldb_, int M, int N, int G_, int c_) { A = A_; B = B_; lda = lda_; ldb = ldb_; nM = M / BM; nN = N / BM; nwg = nM * nN; G = G_; c = c_; }
    __device__ bool next(int i, Unit& u) const {
        const long L = (long)i * G + c; if (L >= nwg) return false;
        int wgid = (int)L; { const int q = nwg / 8, r = nwg % 8, xcd = wgid % 8, off = wgid / 8; wgid = (xcd < r ? xcd * (q + 1) : r * (q + 1) + (xcd - r) * q) + off; }
        const int nig = 8 * nN, gid = wgid / nig, fm = gid * 8, gsz = (nM - fm) < 8 ? (nM - fm) : 8;
        const int pm = fm + ((wgid % nig) % gsz), pn = (wgid % nig) / gsz;
        u.row0 = pm * BM; u.col0 = pn * BM; u.nvalid = BM; u.aux = pn; return true;
    }
    __device__ const char* aptr(const Unit& u) const { return (const char*)(A + (size_t)u.row0 * lda); }
    __device__ const char* bptr(const Unit& u) const { return (const char*)(B + (size_t)u.col0 * ldb); }
};
struct BatchSched : RegSched {
    __device__ const char* bptr(const Unit& u) const { return (const char*)(B + (u.row0 >= SEQ ? (size_t)DM * DM : 0) + (size_t)u.col0 * ldb); }
};
struct AttSched {
    const bf16_t* A; const bf16_t* B; int pv, G, c, skip;
    __device__ bool next(int i, Unit& u) const {
        int L;
        if (skip) L = i * G + c + skip;
        else if (G == 256) { if (c < 64) L = (i == 0) ? c : (i == 1 ? 512 + c : 1 << 20); else L = c + 192 * i; if (c >= 64 && L >= 512) L = 1 << 20; }
        else L = i * G + c;
        if (L >= 512 + 64) return false;
        if (L < 512) { const int pm = L >> 2, h = L & 3; u.row0 = pm * 256; u.col0 = h * 256; u.nvalid = 256; u.aux = pm >> 6; }
        else { const int idx = L - 512, js = idx >> 2, h = idx & 3; u.row0 = NP + NST * js + NST - 256; u.col0 = h * 256; u.nvalid = -NST; u.aux = 2 + js; }
        return true;
    }
    __device__ const char* aptr(const Unit& u) const { return (const char*)(A + (size_t)u.row0 * DM + u.col0); }
    __device__ const char* bptr(const Unit& u) const {
        return (const char*)(pv ? B + (size_t)u.aux * (DM * NMEM) + (size_t)u.col0 * NMEM : B + (size_t)u.aux * (NMEM * DM) + u.col0); }
};

#define EPI_FOR_ROWS for (int ai = 0; ai < 2; ++ai) _Pragma("unroll") for (int m = 0; m < 4; ++m)
__device__ __forceinline__ u32x4 pack8(const f32x4 a, const f32x4 b) { u32x4 w; w.x = cvt_pk_bf16(a[0], a[1]); w.y = cvt_pk_bf16(a[2], a[3]); w.z = cvt_pk_bf16(b[0], b[1]); w.w = cvt_pk_bf16(b[2], b[3]); return w; }
__device__ __forceinline__ void unpack8(const u32x4 w, f32x4& a, f32x4& b) { a = (f32x4){bf_lo(w.x), bf_hi(w.x), bf_lo(w.y), bf_hi(w.y)}; b = (f32x4){bf_lo(w.z), bf_hi(w.z), bf_lo(w.w), bf_hi(w.w)}; }

template <int MODE> struct EpiGen {
    static constexpr bool PERM = true;
    void* O; int ldo; const bf16_t* res; int ldr; const float* bias; float scale;
    __device__ __forceinline__ void piece(size_t row, int col, f32x4 v0, f32x4 v1, const f32x4 b0, const f32x4 b1) const {
        if constexpr (MODE == 0) { v0 = v0 * scale; v1 = v1 * scale; *(u32x4*)((bf16_t*)O + row * ldo + col) = pack8(v0, v1); }
        if constexpr (MODE == 1) { f32x4 r0, r1; unpack8(*(const u32x4*)(res + row * ldr + col), r0, r1); v0 = r0 * ALPHA + v0; v1 = r1 * ALPHA + v1; *(u32x4*)((bf16_t*)O + row * ldo + col) = pack8(v0, v1); }
        if constexpr (MODE == 2) { v0 = v0 + b0; v1 = v1 + b1;
#pragma unroll
            for (int e = 0; e < 4; ++e) { const float a = fmaxf(v0[e], 0.f), b = fmaxf(v1[e], 0.f); v0[e] = a * a; v1[e] = b * b; }
            *(u32x4*)((bf16_t*)O + row * ldo + col) = pack8(v0, v1); }
        if constexpr (MODE == 3) { f32x4 r0, r1; unpack8(*(const u32x4*)(res + row * ldr + col), r0, r1); v0 = r0 * ALPHA + v0 + b0; v1 = r1 * ALPHA + v1 + b1;
            float* o = (float*)O + row * ldo + col; *(f32x4*)o = v0; *(f32x4*)(o + 4) = v1; }
        if constexpr (MODE == 4) { f32x4 r0, r1; unpack8(*(const u32x4*)(res + row * ldr + col), r0, r1); v0 = v0 + b0; v1 = v1 + b1;
#pragma unroll
            for (int e = 0; e < 4; ++e) { v0[e] = r0[e] * sigmoidf_(v0[e]); v1[e] = r1[e] * sigmoidf_(v1[e]); }
            *(u32x4*)((bf16_t*)O + row * ldo + col) = pack8(v0, v1); }
    }
    __device__ __forceinline__ void small(size_t row, int col, const f32x4 v0, const f32x4 v1) const {
        const f32x4 z = (f32x4){0.f, 0.f, 0.f, 0.f};
        piece(row, col, v0, v1, (MODE >= 2) ? *(const f32x4*)(bias + col) : z, (MODE >= 2) ? *(const f32x4*)(bias + col + 4) : z);
    }
    __device__ __forceinline__ void operator()(const f32x4 (&acc)[2][2][4][2], const Unit& u, int wr, int wc, int fr_, int fq_, LAS unsigned char*) const {
        int fr = fr_, fq = fq_; asm volatile("" : "+v"(fr), "+v"(fq));
        const int colb = u.col0 + wc * 32 + 8 * fq;
        f32x4 bv[2][2];
#pragma unroll
        for (int bj = 0; bj < 2; ++bj)
#pragma unroll
            for (int n = 0; n < 2; ++n) bv[bj][n] = (MODE >= 2) ? *(const f32x4*)(bias + colb + bj * HALF + 4 * n) : (f32x4){0.f, 0.f, 0.f, 0.f};
#pragma unroll
        EPI_FOR_ROWS {
            const int rl = ai * HALF + wr * 64 + m * 16 + fr; const size_t row = (size_t)u.row0 + rl;
            if (MODE == 0 && !(u.nvalid >= 0 ? rl < u.nvalid : rl >= 256 + u.nvalid)) continue;
#pragma unroll
            for (int bj = 0; bj < 2; ++bj) piece(row, colb + bj * HALF, acc[ai][bj][m][0], acc[ai][bj][m][1], bv[bj][0], bv[bj][1]);
        }
    }
};

template <int MODE> struct EpiLn {
    static constexpr bool PERM = true, CONS = (MODE != 1), PROD = (MODE == 1 || MODE == 3), RECOMP = (MODE == 3 || MODE == 5);
    void* O; int ldo; const bf16_t* Tin; const f32x2* st_in; f32x2* st_out; const float* va; const float* vb; const float* bias; float scale; int tag0;
    __device__ __forceinline__ void piece(size_t row, int col, f32x4 v0, f32x4 v1, const f32x4 a0, const f32x4 a1, const f32x4 b0, const f32x4 b1, const f32x4 c0, const f32x4 c1,
                                          float mean, float rstd, float& s, float& ss) const {
        if constexpr (MODE == 1) { f32x4 r0, r1; unpack8(*(const u32x4*)(Tin + row * DM + col), r0, r1); v0 = r0 * ALPHA + v0; v1 = r1 * ALPHA + v1; }
        if constexpr (MODE == 2) { v0 = ((v0 - a0 * mean) * rstd + b0) * scale; v1 = ((v1 - a1 * mean) * rstd + b1) * scale; }
        if constexpr (RECOMP) { f32x4 r0, r1; unpack8(*(const u32x4*)(Tin + row * DM + col), r0, r1);
            r0 = (r0 - mean) * rstd * a0 + b0; r1 = (r1 - mean) * rstd * a1 + b1; v0 = r0 * ALPHA + v0; v1 = r1 * ALPHA + v1;
            if constexpr (MODE == 5) { v0 = v0 + c0; v1 = v1 + c1; } }
        if constexpr (MODE == 4) { v0 = (v0 - a0 * mean) * rstd + b0; v1 = (v1 - a1 * mean) * rstd + b1;
#pragma unroll
            for (int e = 0; e < 4; ++e) { const float x = fmaxf(v0[e], 0.f), y = fmaxf(v1[e], 0.f); v0[e] = x * x; v1[e] = y * y; } }
        if constexpr (PROD) {
#pragma unroll
            for (int e = 0; e < 4; ++e) { s += v0[e] + v1[e]; ss += v0[e] * v0[e] + v1[e] * v1[e]; } }
        if constexpr (MODE == 5) { float* o = (float*)O + row * ldo + col; *(f32x4*)o = v0; *(f32x4*)(o + 4) = v1; }
        else *(u32x4*)((bf16_t*)O + row * ldo + col) = pack8(v0, v1);
    }
    __device__ __forceinline__ static void stats_of(const f32x2* st, size_t row, int h, float& s, float& ss) {
        const f32x4* sp = (const f32x4*)(st + row * 16 + h * 8); s = 0.f; ss = 0.f;
#pragma unroll
        for (int q = 0; q < 4; ++q) { const f32x4 v = sp[q]; s += v[0] + v[2]; ss += v[1] + v[3]; }
    }
    __device__ __forceinline__ void small(size_t row, int col, const f32x4 v0, const f32x4 v1) const {
        const f32x4 z = (f32x4){0.f, 0.f, 0.f, 0.f};
        float mean = 0.f, rstd = 0.f;
        if constexpr (CONS) { float s0, q0, s1, q1; stats_of(st_in, row, 0, s0, q0); stats_of(st_in, row, 1, s1, q1); mean = (s0 + s1) * (1.f / DM); rstd = __builtin_amdgcn_rsqf(fmaxf((q0 + q1) * (1.f / DM) - mean * mean, 0.f) + LN_EPS); }
        float s = 0.f, ss = 0.f;
        piece(row, col, v0, v1, CONS ? *(const f32x4*)(va + col) : z, CONS ? *(const f32x4*)(va + col + 4) : z, CONS ? *(const f32x4*)(vb + col) : z, CONS ? *(const f32x4*)(vb + col + 4) : z,
              (MODE == 5) ? *(const f32x4*)(bias + col) : z, (MODE == 5) ? *(const f32x4*)(bias + col + 4) : z, mean, rstd, s, ss);
        if constexpr (PROD) { s += __shfl_xor(s, 1); ss += __shfl_xor(ss, 1); s += __shfl_xor(s, 2); ss += __shfl_xor(ss, 2); s += __shfl_xor(s, 4); ss += __shfl_xor(ss, 4);
            if ((threadIdx.x & 7) == 0) st_out[row * 16 + (col >> 6)] = (f32x2){s, ss}; }
    }
    __device__ __forceinline__ void operator()(const f32x4 (&acc)[2][2][4][2], const Unit& u, int wr, int wc, int fr_, int fq_, LAS unsigned char* ldsx) const {
        int fr = fr_, fq = fq_; asm volatile("" : "+v"(fr), "+v"(fq));
        LAS f32x2* X = (LAS f32x2*)ldsx;
        X += (u.row0 == tag0) ? 0 : 256;
        const int colb = u.col0 + wc * 32 + 8 * fq;
        const f32x4 z = (f32x4){0.f, 0.f, 0.f, 0.f};
        f32x4 av[2][2], bv[2][2], cv[2][2];
#pragma unroll
        for (int bj = 0; bj < 2; ++bj)
#pragma unroll
            for (int n = 0; n < 2; ++n) { av[bj][n] = CONS ? *(const f32x4*)(va + colb + bj * HALF + 4 * n) : z; bv[bj][n] = CONS ? *(const f32x4*)(vb + colb + bj * HALF + 4 * n) : z;
                                          cv[bj][n] = (MODE == 5) ? *(const f32x4*)(bias + colb + bj * HALF + 4 * n) : z; }
#pragma unroll
        EPI_FOR_ROWS {
            const int rl = ai * HALF + wr * 64 + m * 16 + fr; const size_t row = (size_t)u.row0 + rl;
            float mean = 0.f, rstd = 0.f; if constexpr (CONS) { const f32x2 st = X[rl]; mean = st.x; rstd = st.y; }
            float s = 0.f, ss = 0.f;
#pragma unroll
            for (int bj = 0; bj < 2; ++bj) piece(row, colb + bj * HALF, acc[ai][bj][m][0], acc[ai][bj][m][1], av[bj][0], av[bj][1], bv[bj][0], bv[bj][1], cv[bj][0], cv[bj][1], mean, rstd, s, ss);
            if constexpr (PROD) { s += __shfl_xor(s, 16); ss += __shfl_xor(ss, 16); s += __shfl_xor(s, 32); ss += __shfl_xor(ss, 32);
                if (fq == 0) st_out[row * 16 + (u.col0 >> 8) * 4 + wc] = (f32x2){s, ss}; }
        }
    }
    template <class Sched> __device__ __forceinline__ void prep(const Sched& S, LAS unsigned char* ldsx) {
        Unit u; int t0 = 0, t1 = 0; bool any = S.next(0, u);
        if (any) { t0 = u.row0; t1 = t0; for (int i = 1; S.next(i, u); ++i) if (u.row0 != t0) { t1 = u.row0; break; } }
        tag0 = t0;
        if (any) {
            LAS f32x2* X = (LAS f32x2*)ldsx; int t = threadIdx.x; asm volatile("" : "+v"(t));
#pragma unroll
            for (int e = 0; e < 2; ++e) { float s, q; stats_of(st_in, (size_t)(e ? t1 : t0) + (t >> 1), t & 1, s, q);
                s += __shfl_xor(s, 1); q += __shfl_xor(q, 1);
                const float mean = s * (1.f / DM);
                if ((t & 1) == 0) X[e * 256 + (t >> 1)] = (f32x2){mean, __builtin_amdgcn_rsqf(fmaxf(q * (1.f / DM) - mean * mean, 0.f) + LN_EPS)}; }
        }
        __syncthreads();
    }
};
struct EpiWin {
    static constexpr bool PERM = true;
    bf16_t* Ub; bf16_t* Vb; float* out;
    __device__ __forceinline__ void conv_piece(size_t row, int ch, f32x4 v0, f32x4 v1, const f32x4 g0, const f32x4 g1) const {
#pragma unroll
        for (int e = 0; e < 4; ++e) { v0[e] *= sigmoidf_(g0[e]); v1[e] *= sigmoidf_(g1[e]); }
        *(u32x4*)(Vb + row * DCONV + ch) = pack8(v0, v1);
        float* dst = nullptr;
        if (row >= (size_t)NP) { const int r = (int)row - NP; dst = out + O_CVS + (size_t)((r >> 4) * 30 + 14 + (r & 15)) * DCONV + ch; }
        else { const int t = (int)row & (SEQ - 1); if (t >= SEQ - 30) dst = out + O_CVP + (size_t)(((int)row >> 14) * 30 + (t - (SEQ - 30))) * DCONV + ch; }
        if (dst) { *(f32x4*)dst = v0; *(f32x4*)(dst + 4) = v1; }
    }
    __device__ __forceinline__ void small(size_t row, int col, const f32x4 v0, const f32x4 v1) const { *(u32x4*)(Ub + row * DSSM + col) = pack8(v0, v1); }
    __device__ __forceinline__ void operator()(const f32x4 (&acc)[2][2][4][2], const Unit& u, int wr, int wc, int fr_, int fq_, LAS unsigned char*) const {
        int fr = fr_, fq = fq_; asm volatile("" : "+v"(fr), "+v"(fq));
        const int pn = u.aux;
#pragma unroll
        EPI_FOR_ROWS {
            const int rl = ai * HALF + wr * 64 + m * 16 + fr; const size_t row = (size_t)u.row0 + rl;
            if (pn < 2) {
#pragma unroll
                for (int bj = 0; bj < 2; ++bj) *(u32x4*)(Ub + row * DSSM + pn * 256 + bj * HALF + wc * 32 + 8 * fq) = pack8(acc[ai][bj][m][0], acc[ai][bj][m][1]);
            } else {
                conv_piece(row, (pn - 2) * 128 + wc * 32 + 8 * fq, acc[ai][0][m][0], acc[ai][0][m][1], acc[ai][1][m][0], acc[ai][1][m][1]);
            }
        }
    }
};
struct EpiKv {
    static constexpr bool PERM = true;
    bf16_t* Kb; bf16_t* Vt; float* out; int kind; bf16_t* V16;
    __device__ __forceinline__ void small(size_t row, int col, const f32x4 v0, const f32x4 v1) const {
        if (kind == 0) { float* o = out + O_MKP + row * DM + col; *(f32x4*)o = v0; *(f32x4*)(o + 4) = v1; *(u32x4*)(Kb + row * DM + col) = pack8(v0, v1); }
        else if (kind == 1) { float* o = out + O_MVP + row * DM + col; *(f32x4*)o = v0; *(f32x4*)(o + 4) = v1; *(u32x4*)(V16 + row * DM + col) = pack8(v0, v1); }
        else { const int b = col >> 8, key = col & 255; *(u32x4*)(Vt + (size_t)b * (DM * NMEM) + row * NMEM + key) = pack8(v0, v1); }
    }
};
struct EpiSoftmax {
    static constexpr bool PERM = true;
    bf16_t* P;
    __device__ __forceinline__ void operator()(f32x4 (&acc)[2][2][4][2], const Unit& u, int wr, int wc, int fr_, int fq_, LAS unsigned char* ldsx) const {
        int fr = fr_, fq = fq_; asm volatile("" : "+v"(fr), "+v"(fq));
        LAS f32x2* X = (LAS f32x2*)ldsx;
        float mx[2][4];
#pragma unroll
        EPI_FOR_ROWS {
            float mv = -3.0e38f;
#pragma unroll
            for (int bj = 0; bj < 2; ++bj)
#pragma unroll
                for (int n = 0; n < 2; ++n)
#pragma unroll
                    for (int e = 0; e < 4; ++e) mv = fmaxf(mv, acc[ai][bj][m][n][e]);
            mv = fmaxf(mv, __shfl_xor(mv, 16)); mv = fmaxf(mv, __shfl_xor(mv, 32));
            float s = 0.f;
#pragma unroll
            for (int bj = 0; bj < 2; ++bj)
#pragma unroll
                for (int n = 0; n < 2; ++n)
#pragma unroll
                    for (int e = 0; e < 4; ++e) { const float pe = __expf(acc[ai][bj][m][n][e] - mv); acc[ai][bj][m][n][e] = pe; s += pe; }
            s += __shfl_xor(s, 16); s += __shfl_xor(s, 32);
            mx[ai][m] = mv;
            if (fq == 0) X[(ai * HALF + wr * 64 + m * 16 + fr) * 4 + wc] = (f32x2){mv, s};
        }
        asm volatile("s_waitcnt lgkmcnt(0)" ::: "memory"); __builtin_amdgcn_s_barrier(); asm volatile("" ::: "memory");
#pragma unroll
        EPI_FOR_ROWS {
            const int rl = ai * HALF + wr * 64 + m * 16 + fr;
            const f32x2 a = X[rl * 4 + 0], b = X[rl * 4 + 1], c = X[rl * 4 + 2], d = X[rl * 4 + 3];
            const float M = fmaxf(fmaxf(a.x, b.x), fmaxf(c.x, d.x));
            const float Lsum = a.y * __expf(a.x - M) + b.y * __expf(b.x - M) + c.y * __expf(c.x - M) + d.y * __expf(d.x - M);
            const float sc = __expf(mx[ai][m] - M) * __builtin_amdgcn_rcpf(Lsum);
            if (u.nvalid >= 0 ? rl < u.nvalid : rl >= 256 + u.nvalid) {
                const size_t row = (size_t)u.row0 + rl;
#pragma unroll
                for (int bj = 0; bj < 2; ++bj) *(u32x4*)(P + row * DM + u.col0 + bj * HALF + wc * 32 + 8 * fq) = pack8(acc[ai][bj][m][0] * sc, acc[ai][bj][m][1] * sc);
            }
            asm volatile("" ::: "memory");
        }
        asm volatile("s_waitcnt lgkmcnt(0)" ::: "memory"); __builtin_amdgcn_s_barrier(); asm volatile("" ::: "memory");
    }
};
}

template <class Epi, bool PAIR>
__device__ __forceinline__ void small_gemm(LAS unsigned char* lds, const bf16_t* A, int lda, const bf16_t* B, int ldb, int K, int nrg, int nct, size_t row_base, int col_base, const Epi& E, int G, int c) {
    int tid = threadIdx.x; asm volatile("" : "+v"(tid));
    const int wid = __builtin_amdgcn_readfirstlane(tid >> 6), lane = tid & 63, fr = lane & 15, fq = lane >> 4;
    LAS float* red = (LAS float*)lds;
    const int kw = K >> 3, k0 = wid * kw, nks = kw >> 5;
    for (int unit = c; unit < nrg * nct; unit += G) {
        const int rg = unit % nrg, ct = unit / nrg;
        f32x4 acc[4][4];
#pragma unroll
        for (int mi = 0; mi < 4; ++mi)
#pragma unroll
            for (int ni = 0; ni < 4; ++ni) acc[mi][ni] = (f32x4){0.f, 0.f, 0.f, 0.f};
        const bf16_t* ap = A + (size_t)(rg * 64 + fr) * lda + k0 + fq * 8;
        const bf16_t* bp;
        if (PAIR) { const int ch0 = 32 * ct; bp = B + (size_t)(DSSM + 256 * (ch0 >> 7) + (ch0 & 127) + fr) * ldb + k0 + fq * 8; }
        else bp = B + (size_t)(ct * 64 + fr) * ldb + k0 + fq * 8;
#pragma unroll 4
        for (int ks = 0; ks < nks; ++ks) {
            bf16x8 a[4], b[4];
#pragma unroll
            for (int mi = 0; mi < 4; ++mi) a[mi] = *(const bf16x8*)(ap + (size_t)(mi * 16) * lda + ks * 32);
#pragma unroll
            for (int ni = 0; ni < 4; ++ni) { const int roff = PAIR ? ((ni & 1) * 16 + (ni >> 1) * 128) : ni * 16; b[ni] = *(const bf16x8*)(bp + (size_t)roff * ldb + ks * 32); }
#pragma unroll
            for (int mi = 0; mi < 4; ++mi)
#pragma unroll
                for (int ni = 0; ni < 4; ++ni) acc[mi][ni] = __builtin_amdgcn_mfma_f32_16x16x32_bf16(b[ni], a[mi], acc[mi][ni], 0, 0, 0);
        }
        __syncthreads();
#pragma unroll
        for (int mi = 0; mi < 4; ++mi)
#pragma unroll
            for (int ni = 0; ni < 4; ++ni) *(LAS f32x4*)(red + (wid * 64 + mi * 16 + fr) * 68 + ni * 16 + 4 * fq) = acc[mi][ni];
        __syncthreads();
        if constexpr (!PAIR) {
            const int r = tid >> 3, pc = tid & 7; f32x4 v0 = (f32x4){0.f, 0.f, 0.f, 0.f}, v1 = v0;
#pragma unroll
            for (int w = 0; w < 8; ++w) { v0 += *(const LAS f32x4*)(red + (w * 64 + r) * 68 + pc * 8); v1 += *(const LAS f32x4*)(red + (w * 64 + r) * 68 + pc * 8 + 4); }
            E.small(row_base + rg * 64 + r, col_base + ct * 64 + pc * 8, v0, v1);
        } else { if (tid < 256) {
            const int r = tid >> 2, pc = tid & 3; f32x4 v0 = (f32x4){0.f, 0.f, 0.f, 0.f}, v1 = v0, g0 = v0, g1 = v0;
#pragma unroll
            for (int w = 0; w < 8; ++w) { const LAS float* q = red + (w * 64 + r) * 68 + pc * 8;
                v0 += *(const LAS f32x4*)q; v1 += *(const LAS f32x4*)(q + 4); g0 += *(const LAS f32x4*)(q + 32); g1 += *(const LAS f32x4*)(q + 36); }
            E.conv_piece(row_base + rg * 64 + r, 32 * ct + pc * 8, v0, v1, g0, g1);
        } }
    }
    __syncthreads();
}

struct Frame {
    LAS unsigned char* lds; int tid, lane, wave, G, vcu;
};
__device__ __forceinline__ Frame fresh(const Frame& F0) { Frame F = F0; int t = threadIdx.x; asm volatile("" : "+v"(t)); F.tid = t; F.lane = t & 63; F.wave = __builtin_amdgcn_readfirstlane(t >> 6); return F; }

__device__ __forceinline__ void transpose_item(const float* W, int K, int N, bf16_t* WT, int ldt, int k0, int n0, int drow0, LAS float* scr, int lane,
                                               const float* gam = nullptr, const float* bet = nullptr, float* csp = nullptr, float* bcp = nullptr) {
    float tv[32];
#pragma unroll
    for (int i = 0; i < 32; ++i) tv[i] = __builtin_nontemporal_load(W + (size_t)(k0 + 2 * i + (lane >> 5)) * N + n0 + (lane & 31));
#pragma unroll
    for (int i = 0; i < 32; ++i) scr[(2 * i + (lane >> 5)) * 33 + (lane & 31)] = tv[i];
    asm volatile("s_waitcnt lgkmcnt(0)" ::: "memory");
    const int c = lane & 7;
    float ge[8], be[8];
#pragma unroll
    for (int e = 0; e < 8; ++e) { ge[e] = gam ? gam[k0 + 8 * c + e] : 1.f; be[e] = gam ? bet[k0 + 8 * c + e] : 0.f; }
#pragma unroll
    for (int j = 0; j < 4; ++j) { const int n = (lane >> 3) + 8 * j; const LAS float* sp = scr + (8 * c) * 33 + n;
        float w[8];
#pragma unroll
        for (int e = 0; e < 8; ++e) w[e] = sp[e * 33];
        u32x4 o; o.x = cvt_pk_bf16(w[0] * ge[0], w[1] * ge[1]); o.y = cvt_pk_bf16(w[2] * ge[2], w[3] * ge[3]); o.z = cvt_pk_bf16(w[4] * ge[4], w[5] * ge[5]); o.w = cvt_pk_bf16(w[6] * ge[6], w[7] * ge[7]);
        *(u32x4*)(WT + (size_t)(drow0 + n) * ldt + k0 + 8 * c) = o;
        if (gam) {
            float cs = (bf_lo(o.x) + bf_hi(o.x)) + (bf_lo(o.y) + bf_hi(o.y)) + (bf_lo(o.z) + bf_hi(o.z)) + (bf_lo(o.w) + bf_hi(o.w)), bc = 0.f;
#pragma unroll
            for (int e = 0; e < 8; ++e) bc += w[e] * be[e];
            cs += __shfl_xor(cs, 1); cs += __shfl_xor(cs, 2); cs += __shfl_xor(cs, 4); bc += __shfl_xor(bc, 1); bc += __shfl_xor(bc, 2); bc += __shfl_xor(bc, 4);
            if (c == 0) { csp[(size_t)(k0 >> 6) * N + n0 + n] = cs; bcp[(size_t)(k0 >> 6) * N + n0 + n] = bc; }
        }
    }
    asm volatile("s_waitcnt lgkmcnt(0)" ::: "memory");
}
__device__ __forceinline__ int win_dest_row(int n0) {
    if (n0 < DSSM) return n0;
    const int cc = n0 - DSSM;
    if (cc < DCONV) return DSSM + 256 * (cc >> 7) + (cc & 127);
    const int c2 = cc - DCONV; return DSSM + 256 * (c2 >> 7) + 128 + (c2 & 127);
}

__device__ __forceinline__ void ssm_tables(const Params& p, int g, int part, LAS float* sm, int tid) {
    LAS float* pwr = sm;
    LAS float* pwi = sm + 576;
    LAS float* cfr = sm + 1152;
    LAS float* cfi = sm + 1216;
    LAS float* bbr = sm + 1280;
    LAS float* bbi = sm + 2304;
    LAS float* cre = sm + 3328;
    LAS float* cim = sm + 4352;
    LAS float* kc = sm + 5376;
    const float* a_re = p.in[9] + g * 64; const float* a_im = p.in[10] + g * 64; const float* b_re = p.in[12] + (size_t)g * 1024; const float* b_im = p.in[13] + (size_t)g * 1024;
    const float* c_re = p.in[14] + (size_t)g * 1024; const float* c_im = p.in[15] + (size_t)g * 1024;
    const int fa = 12 * part, fb = fa + 12;
    __syncthreads();
    if (tid < 64) {
        const float are = a_re[tid], aim = a_im[tid], dt = expf(p.in[11][g]);
        const float mag = expf(are * dt), ang = aim * dt;
        float sn, cs; sincosf(ang, &sn, &cs);
        const float abr = mag * cs, abi = mag * sn, den = are * are + aim * aim, pp = abr - 1.f, q = abi;
        cfr[tid] = (pp * are + q * aim) / den; cfi[tid] = (q * are - pp * aim) / den;
        float xr = 1.f, xi = 0.f;
#pragma unroll
        for (int k = 0; k < 9; ++k) { pwr[k * 64 + tid] = xr; pwi[k * 64 + tid] = xi; const float nr = xr * abr - xi * abi, ni = xr * abi + xi * abr; xr = nr; xi = ni; }
        if (part == 0) ((f32x2*)(p.ws + WS_M1))[g * 64 + tid] = (f32x2){pwr[8 * 64 + tid], pwi[8 * 64 + tid]};
    }
    for (int e = tid; e < 1024; e += 512) { cre[e] = c_re[e]; cim[e] = c_im[e]; }
    __syncthreads();
    for (int e = tid; e < 1024; e += 512) { const int n = e >> 4; const float br = b_re[e], bi = b_im[e]; bbr[e] = cfr[n] * br - cfi[n] * bi; bbi[e] = cfr[n] * bi + cfi[n] * br; }
    __syncthreads();
    if (fa < 64 && fb > 32) {
        for (int e = tid; e < 2048; e += 512) { const int l = e >> 8, pch = (e >> 4) & 15, q = e & 15; float s = 0.f;
            for (int n = 0; n < 64; ++n) { const float cr = cre[pch * 64 + n], ci = cim[pch * 64 + n], ar = pwr[l * 64 + n], ai = pwi[l * 64 + n];
                const float zr = cr * ar - ci * ai, zi = cr * ai + ci * ar; s += zr * bbr[n * 16 + q] - zi * bbi[n * 16 + q]; }
            kc[e] = s; }
    }
    __syncthreads();
    bf16_t* dst = (bf16_t*)(p.ws + WS_SSMW) + (size_t)g * SSM_FRAG_ELEMS;
    for (int e = fa * 512 + tid; e < fb * 512; e += 512) {
        const int f = e >> 9, l = (e >> 3) & 63, ee = e & 7, lo = l & 15, gq = l >> 4; float v;
        if (f < 32) { const int i = f >> 2, ks = f & 3, np = 16 * i + lo, k = 32 * ks + 8 * gq + ee, sI = k >> 4, q = k & 15, n = np & 63;
            const float ar = pwr[(7 - sI) * 64 + n], ai = pwi[(7 - sI) * 64 + n], br = bbr[n * 16 + q], bi = bbi[n * 16 + q];
            v = (np < 64) ? (ar * br - ai * bi) : (ar * bi + ai * br); }
        else if (f < 64) { const int t = (f - 32) >> 2, ks = (f - 32) & 3, k = 32 * ks + 8 * gq + ee, sI = k >> 4, q = k & 15;
            v = (sI <= t) ? kc[(t - sI) * 256 + lo * 16 + q] : 0.f; }
        else { const int t = (f - 64) >> 2, kap = (f - 64) & 3, tile = (ee < 4) ? 2 * kap : 2 * kap + 1, np = 16 * tile + 4 * gq + (ee & 3), n = np & 63;
            const float cr = cre[lo * 64 + n], ci = cim[lo * 64 + n], ar = pwr[(t + 1) * 64 + n], ai = pwi[(t + 1) * 64 + n];
            v = (np < 64) ? (cr * ar - ci * ai) : -(cr * ai + ci * ar); }
        dst[e] = f2bf(v);
    }
}

__device__ __forceinline__ void p0_prologue(const Params& p, const Frame& F0) {
    const Frame F = fresh(F0);
    LAS float* scr = (LAS float*)(F.lds + F.wave * 16384);
    const int gw = F.vcu * 8 + F.wave, NGW = F.G * 8;
    bf16_t* Win_t = (bf16_t*)(p.ws + WS_WIN); bf16_t* Glu_t = (bf16_t*)(p.ws + WS_GLU); bf16_t* Wout_t = (bf16_t*)(p.ws + WS_WOUT); bf16_t* Wq_t = (bf16_t*)(p.ws + WS_WQ);
    bf16_t* Wkv_t = (bf16_t*)(p.ws + WS_WKV); bf16_t* Wo_t = (bf16_t*)(p.ws + WS_WO); bf16_t* W1_t = (bf16_t*)(p.ws + WS_W1); bf16_t* W2_t = (bf16_t*)(p.ws + WS_W2);
    bf16_t* Vt = (bf16_t*)(p.ws + WS_VT);
    constexpr int I_IN = 16 * 48, I_GLU = 8 * 16, I_SQ = 16 * 32, I_1 = 16 * 128, I_2 = 64 * 32, I_VT = 16 * 4 * 32;
    constexpr int NITEMS = I_IN + I_GLU + 5 * I_SQ + I_1 + I_2 + I_VT;
    for (int it = gw; it < NITEMS; it += NGW) {
        int r = it;
        if (r < I_IN) { const int kb = r / 48, nb = r % 48; transpose_item(p.in[8], DM, DIN, Win_t, DM, 64 * kb, 32 * nb, win_dest_row(32 * nb), scr, F.lane); continue; } r -= I_IN;
        if (r < I_GLU) { const int kb = r / 16, nb = r % 16; transpose_item(p.in[17], DSSM, DSSM, Glu_t, DSSM, 64 * kb, 32 * nb, 32 * nb, scr, F.lane); continue; } r -= I_GLU;
        if (r < 5 * I_SQ) { const int w = r / I_SQ, q = r % I_SQ, kb = q / 32, nb = q % 32;
            const float* src = w == 0 ? p.in[23] : w == 1 ? p.in[26] : w == 2 ? p.in[27] : w == 3 ? p.in[28] : p.in[29];
            bf16_t* dst = w == 0 ? Wout_t : w == 1 ? Wq_t : w == 2 ? Wkv_t : w == 3 ? Wkv_t + (size_t)DM * DM : Wo_t;
            float* csp = (float*)(p.ws + WS_CSP);
            if (w == 1) transpose_item(src, DM, DM, dst, DM, 64 * kb, 32 * nb, 32 * nb, scr, F.lane, p.in[24], p.in[25], csp, csp + 16 * DM);
            else transpose_item(src, DM, DM, dst, DM, 64 * kb, 32 * nb, 32 * nb, scr, F.lane);
            continue; } r -= 5 * I_SQ;
        if (r < I_1) { const int kb = r / 128, nb = r % 128; float* csp = (float*)(p.ws + WS_CSP) + 32 * DM; transpose_item(p.in[32], DM, DFF, W1_t, DM, 64 * kb, 32 * nb, 32 * nb, scr, F.lane, p.in[30], p.in[31], csp, csp + 16 * DFF); continue; } r -= I_1;
        if (r < I_2) { const int kb = r / 32, nb = r % 32; transpose_item(p.in[34], DFF, DM, W2_t, DFF, 64 * kb, 32 * nb, 32 * nb, scr, F.lane); continue; } r -= I_2;
        { const int js = r / 128, q = r % 128, kb = q / 32, nb = q % 32;
          transpose_item(p.in[6] + (size_t)js * NMEM * DM, NMEM, DM, Vt + (size_t)(2 + js) * DM * NMEM, NMEM, 64 * kb, 32 * nb, 32 * nb, scr, F.lane); }
    }
    {
        const size_t gt = (size_t)F.vcu * 512 + F.tid, NT = (size_t)F.G * 512;
        bf16_t* Xb = (bf16_t*)(p.ws + WS_XB); bf16_t* Kb = (bf16_t*)(p.ws + WS_KB); bf16_t* Mb = (bf16_t*)(p.ws + WS_MEMB);
        constexpr size_t C_X = (size_t)R * DM / 8, C_XP = (size_t)NP * DM / 8, C_K = (size_t)NSB * NMEM * DM / 8, C_M = (size_t)NB * NMEM * DM / 8;
        constexpr size_t C_ALL = C_X + C_K + C_M;
        for (size_t i0 = gt; i0 < C_ALL; i0 += 4 * NT) {
            f32x4 a[4], b[4]; bf16_t* dst[4]; bool ok[4];
#pragma unroll
            for (int q = 0; q < 4; ++q) {
                const size_t i = i0 + q * NT; ok[q] = i < C_ALL; const size_t ic = ok[q] ? i : gt; const float* src;
                if (ic < C_X) { src = (ic < C_XP) ? p.in[0] + ic * 8 : p.in[1] + (ic - C_XP) * 8; dst[q] = Xb + ic * 8; }
                else if (ic < C_X + C_K) { const size_t k = ic - C_X; src = p.in[5] + k * 8; dst[q] = Kb + (size_t)NB * NMEM * DM + k * 8; }
                else { const size_t k = ic - C_X - C_K; src = p.in[7] + k * 8; dst[q] = Mb + k * 8; }
                a[q] = __builtin_nontemporal_load((const f32x4*)src); b[q] = __builtin_nontemporal_load((const f32x4*)(src + 4));
            }
#pragma unroll
            for (int q = 0; q < 4; ++q) if (ok[q]) *(u32x4*)dst[q] = pg8::pack8(a[q], b[q]);
        }
        for (size_t i = gt; i < (size_t)NSB * 14 * DCONV / 4; i += NT) { const size_t e = i * 4, js = e / (14 * DCONV), rem = e % (14 * DCONV);
            *(f32x4*)(p.out + O_CVS + js * 30 * DCONV + rem) = *(const f32x4*)(p.in[4] + js * 30 * DCONV + 16 * DCONV + rem); }
    }
    for (int w = blockIdx.x; w < NG * 8; w += F.G) ssm_tables(p, w & (NG - 1), w >> 5, (LAS float*)F.lds, F.tid);
    __syncthreads();
}

template <bool PASS2, int SAMP = 0>
__device__ __forceinline__ void ssm_phase(const Params& p, const Frame& F0) {
    const Frame F = fresh(F0);
    const bf16_t* Ub = (const bf16_t*)(p.ws + WS_UB); bf16_t* Zb = (bf16_t*)(p.ws + WS_ZB);
    float* Wst = (float*)(p.ws + WS_WST);
    const int lane = F.lane, j = lane & 15, gq = lane >> 4;
    for (int pr = SAMP ? (int)blockIdx.x - 8 : (int)blockIdx.x; SAMP ? (pr >= 0 && pr < 64) : (pr < 256); pr += F.G) {
        const int g = SAMP ? (pr >> 1) : 4 * (pr & 7) + ((pr >> 3) & 3), subset = SAMP ? 0 : pr >> 5;
        __syncthreads();
        { const u32x4* src = (const u32x4*)((const bf16_t*)(p.ws + WS_SSMW) + (size_t)g * SSM_FRAG_ELEMS);
          for (int e = F.tid; e < SSM_FRAG_ELEMS / 8; e += 512) ((LAS u32x4*)F.lds)[e] = src[e];
          if (F.tid < 64) ((LAS f32x2*)(F.lds + SSM_M1_OFF))[F.tid] = ((const f32x2*)(p.ws + WS_M1))[g * 64 + F.tid]; }
        __syncthreads();
        const LAS bf16x8* frag = (const LAS bf16x8*)F.lds + lane;
        const LAS f32x4* m1t = (const LAS f32x4*)(F.lds + SSM_M1_OFF) + 2 * gq;
        const int b = subset >> 2, wch = (subset & 3) * 8 + F.wave;
        f32x4 xs[8];
#pragma unroll
        for (int i = 0; i < 8; ++i) xs[i] = (f32x4){0.f, 0.f, 0.f, 0.f};
        if (PASS2 && !SAMP && wch > 0) {
            const float* wb = Wst + (size_t)((g * 2 + b) * 32) * 128;
#pragma unroll
            for (int i = 0; i < 4; ++i) {
                __builtin_amdgcn_sched_barrier(0);
                const f32x4 ma = m1t[8 * i], mb = m1t[8 * i + 1];
                float pr_[4] = {ma[0], ma[2], mb[0], mb[2]}, pi_[4] = {ma[1], ma[3], mb[1], mb[3]};
#pragma unroll
                for (int r = 0; r < 4; ++r) {
#pragma unroll
                    for (int s2 = 0; s2 < 6; ++s2) { const float nr = pr_[r] * pr_[r] - pi_[r] * pi_[r], ni = 2.f * pr_[r] * pi_[r]; pr_[r] = nr; pi_[r] = ni; } }
                f32x4 wre[2], wim[2]; int ex[2];
#pragma unroll
                for (int e = 0; e < 2; ++e) { const int w = j + 16 * e; const bool ok = w < wch; ex[e] = ok ? (wch - 1 - w) : 0; const int wc_ = ok ? w : 0;
                    const f32x4 lr = *(const f32x4*)(wb + wc_ * 128 + 16 * i + 4 * gq), li = *(const f32x4*)(wb + wc_ * 128 + 64 + 16 * i + 4 * gq);
                    wre[e] = ok ? lr : (f32x4){0.f, 0.f, 0.f, 0.f}; wim[e] = ok ? li : (f32x4){0.f, 0.f, 0.f, 0.f}; }
                float fr_[2][4], fi_[2][4];
#pragma unroll
                for (int e = 0; e < 2; ++e)
#pragma unroll
                    for (int r = 0; r < 4; ++r) { fr_[e][r] = 1.f; fi_[e][r] = 0.f; }
#pragma unroll
                for (int bit = 0; bit < 5; ++bit) {
#pragma unroll
                    for (int e = 0; e < 2; ++e) { const bool on = (ex[e] >> bit) & 1;
#pragma unroll
                        for (int r = 0; r < 4; ++r) { const float qr = on ? pr_[r] : 1.f, qi = on ? pi_[r] : 0.f;
                            const float nr = fr_[e][r] * qr - fi_[e][r] * qi, ni = fr_[e][r] * qi + fi_[e][r] * qr; fr_[e][r] = nr; fi_[e][r] = ni; } }
                    if (bit < 4) {
#pragma unroll
                        for (int r = 0; r < 4; ++r) { const float nr = pr_[r] * pr_[r] - pi_[r] * pi_[r], ni = 2.f * pr_[r] * pi_[r]; pr_[r] = nr; pi_[r] = ni; } }
                }
                f32x4 hr, hi;
#pragma unroll
                for (int r = 0; r < 4; ++r) { hr[r] = fr_[0][r] * wre[0][r] - fi_[0][r] * wim[0][r] + fr_[1][r] * wre[1][r] - fi_[1][r] * wim[1][r];
                                              hi[r] = fr_[0][r] * wim[0][r] + fi_[0][r] * wre[0][r] + fr_[1][r] * wim[1][r] + fi_[1][r] * wre[1][r]; }
#pragma unroll
                for (int r = 0; r < 4; ++r) { hr[r] += dppf<DPP_SHR(1)>(hr[r]); hi[r] += dppf<DPP_SHR(1)>(hi[r]); hr[r] += dppf<DPP_SHR(2)>(hr[r]); hi[r] += dppf<DPP_SHR(2)>(hi[r]);
                                              hr[r] += dppf<DPP_SHR(4)>(hr[r]); hi[r] += dppf<DPP_SHR(4)>(hi[r]); hr[r] += dppf<DPP_SHR(8)>(hr[r]); hi[r] += dppf<DPP_SHR(8)>(hi[r]); }
                xs[i] = hr; xs[i + 4] = hi;
            }
        }
        const int nch = SAMP ? 5 : 4, cc0 = SAMP ? 4 : 0;
        const int jsamp = SAMP ? (pr & 1) * 8 + F.wave : 0;
#define SSM_ROW0(cc_) (((cc_) == 4) ? (NP + jsamp * NST) : (b * SEQ + (wch * 4 + (cc_)) * 128))
#define SSM_NSUB(cc_) (((cc_) == 4) ? 2 : 16)
#define SSM_LOAD_U(dst, dstu, cc_) { const int r0_ = SSM_ROW0(cc_), ns_ = SSM_NSUB(cc_); const bool ok_ = j < ns_; const int jj_ = ok_ ? j : 0; \
            _Pragma("unroll") for (int ks = 0; ks < 4; ++ks) { const int s_ = 2 * ks + (gq >> 1); \
                const bf16x8 v_ = *(const bf16x8*)(Ub + (size_t)(r0_ + 8 * jj_ + s_) * DSSM + g * 16 + 8 * (gq & 1)); dst[ks] = ok_ ? v_ : (bf16x8){0, 0, 0, 0, 0, 0, 0, 0}; } \
            if (PASS2) { _Pragma("unroll") for (int t = 0; t < 8; ++t) dstu[t] = *(const u32x2*)(Ub + (size_t)(r0_ + 8 * jj_ + t) * DSSM + g * 16 + 4 * gq); } }
        bf16x8 uf[4], ufn[4]; u32x2 uw[8], uwn[8];
        SSM_LOAD_U(uf, uw, cc0)
        for (int cc = cc0; cc < nch; ++cc) {
            asm volatile("" ::: "memory");
            const bool samp = (cc == 4);
            const int row0 = SSM_ROW0(cc), nsub = SSM_NSUB(cc), js = jsamp;
            if (samp) {
#pragma unroll
                for (int i = 0; i < 4; ++i) { xs[i] = *(const f32x4*)(p.in[2] + (size_t)(js * NG + g) * 64 + 16 * i + 4 * gq); xs[i + 4] = *(const f32x4*)(p.in[3] + (size_t)(js * NG + g) * 64 + 16 * i + 4 * gq); } }
            if (cc + 1 < nch) SSM_LOAD_U(ufn, uwn, cc + 1)
            unsigned hw[4][4];
#pragma unroll
            for (int i = 0; i < 4; ++i) {
                __builtin_amdgcn_sched_barrier(0);
                f32x4 Er = (f32x4){0.f, 0.f, 0.f, 0.f}, Ei = Er;
#pragma unroll
                for (int ks = 0; ks < 4; ++ks) { Er = __builtin_amdgcn_mfma_f32_16x16x32_bf16(frag[(i * 4 + ks) * 64], uf[ks], Er, 0, 0, 0);
                                                 Ei = __builtin_amdgcn_mfma_f32_16x16x32_bf16(frag[((i + 4) * 4 + ks) * 64], uf[ks], Ei, 0, 0, 0); }
                const f32x4 ma = m1t[8 * i], mb = m1t[8 * i + 1];
                float mr[4] = {ma[0], ma[2], mb[0], mb[2]}, mi[4] = {ma[1], ma[3], mb[1], mb[3]};
                float hr[4], hi[4];
#pragma unroll
                for (int r = 0; r < 4; ++r) { hr[r] = dppf<DPP_ROR(1)>(xs[i][r]); hi[r] = dppf<DPP_ROR(1)>(xs[i + 4][r]);
                    if (j == 0) { Er[r] += mr[r] * hr[r] - mi[r] * hi[r]; Ei[r] += mr[r] * hi[r] + mi[r] * hr[r]; } }
#define SSM_SCAN_STEP(D, SQ) { _Pragma("unroll") for (int r = 0; r < 4; ++r) { \
                    const float sr = dppf<DPP_SHR(D)>(Er[r]), si = dppf<DPP_SHR(D)>(Ei[r]); \
                    Er[r] += mr[r] * sr - mi[r] * si; Ei[r] += mr[r] * si + mi[r] * sr; \
                    if (SQ) { const float nr = mr[r] * mr[r] - mi[r] * mi[r], ni = 2.f * mr[r] * mi[r]; mr[r] = nr; mi[r] = ni; } } }
                SSM_SCAN_STEP(1, 1) SSM_SCAN_STEP(2, 1) SSM_SCAN_STEP(4, 1) SSM_SCAN_STEP(8, 0)
#undef SSM_SCAN_STEP
                if constexpr (PASS2) {
                    float vr[4], vi[4];
#pragma unroll
                    for (int r = 0; r < 4; ++r) { const float pr_ = dppf<DPP_ROR(1)>(Er[r]), pi_ = dppf<DPP_ROR(1)>(Ei[r]); vr[r] = (j == 0) ? hr[r] : pr_; vi[r] = (j == 0) ? hi[r] : pi_; }
                    hw[i >> 1][2 * (i & 1)] = cvt_pk_bf16(vr[0], vr[1]); hw[i >> 1][2 * (i & 1) + 1] = cvt_pk_bf16(vr[2], vr[3]);
                    hw[2 + (i >> 1)][2 * (i & 1)] = cvt_pk_bf16(vi[0], vi[1]); hw[2 + (i >> 1)][2 * (i & 1) + 1] = cvt_pk_bf16(vi[2], vi[3]);
                }
                xs[i] = Er; xs[i + 4] = Ei;
            }
            __builtin_amdgcn_sched_barrier(0);
            asm volatile("" ::: "memory");
            if constexpr (PASS2) {
                bf16x8 hf[4];
#pragma unroll
                for (int kap = 0; kap < 4; ++kap) hf[kap] = __builtin_bit_cast(bf16x8, (u32x4){hw[kap][0], hw[kap][1], hw[kap][2], hw[kap][3]});
                const f32x4 dv = *(const f32x4*)(p.in[16] + g * 16 + 4 * gq);
#pragma unroll
                for (int t = 0; t < 8; ++t) {
                    asm volatile("" ::: "memory");
                    f32x4 y = (f32x4){0.f, 0.f, 0.f, 0.f};
#pragma unroll
                    for (int ks = 0; ks < 4; ++ks) y = __builtin_amdgcn_mfma_f32_16x16x32_bf16(frag[(32 + t * 4 + ks) * 64], uf[ks], y, 0, 0, 0);
#pragma unroll
                    for (int kap = 0; kap < 4; ++kap) y = __builtin_amdgcn_mfma_f32_16x16x32_bf16(frag[(64 + t * 4 + kap) * 64], hf[kap], y, 0, 0, 0);
                    if (j < nsub) {
                        const size_t off = (size_t)(row0 + 8 * j + t) * DSSM + g * 16 + 4 * gq;
                        const u32x2 uu = uw[t];
                        const float z0 = gelu_tanh(y[0] + dv[0] * bf_lo(uu.x)), z1 = gelu_tanh(y[1] + dv[1] * bf_hi(uu.x)), z2 = gelu_tanh(y[2] + dv[2] * bf_lo(uu.y)), z3 = gelu_tanh(y[3] + dv[3] * bf_hi(uu.y));
                        *(u32x2*)(Zb + off) = (u32x2){cvt_pk_bf16(z0, z1), cvt_pk_bf16(z2, z3)};
                    }
                }
                if (samp) { if (j == 1) {
#pragma unroll
                        for (int i = 0; i < 4; ++i) { *(f32x4*)(p.out + O_SRS + (size_t)(js * NG + g) * 64 + 16 * i + 4 * gq) = xs[i]; *(f32x4*)(p.out + O_SIS + (size_t)(js * NG + g) * 64 + 16 * i + 4 * gq) = xs[i + 4]; } } }
                else if (cc == 3 && wch == 31 && j == 15) {
#pragma unroll
                    for (int i = 0; i < 4; ++i) { *(f32x4*)(p.out + O_SRP + (size_t)(b * NG + g) * 64 + 16 * i + 4 * gq) = xs[i]; *(f32x4*)(p.out + O_SIP + (size_t)(b * NG + g) * 64 + 16 * i + 4 * gq) = xs[i + 4]; }
                }
            }
#pragma unroll
            for (int ks = 0; ks < 4; ++ks) uf[ks] = ufn[ks];
            if (PASS2) {
#pragma unroll
                for (int t = 0; t < 8; ++t) uw[t] = uwn[t]; }
        }
#undef SSM_ROW0
#undef SSM_NSUB
#undef SSM_LOAD_U
        if constexpr (!PASS2) { if (j == 15) { float* wb = Wst + (size_t)((g * 2 + b) * 32 + wch) * 128;
#pragma unroll
                for (int i = 0; i < 4; ++i) { *(f32x4*)(wb + 16 * i + 4 * gq) = xs[i]; *(f32x4*)(wb + 64 + 16 * i + 4 * gq) = xs[i + 4]; } } }
    }
    __syncthreads();
}

template <int PMODE>
__device__ __forceinline__ void conv_phase(const Params& p, const Frame& F0) {
    const Frame F = fresh(F0);
    const bf16_t* Vb = (const bf16_t*)(p.ws + WS_VB); bf16_t* Cat = (bf16_t*)(p.ws + WS_CAT);
    LAS float* red = (LAS float*)F.lds;
    LAS f32x2* stat = (LAS f32x2*)(F.lds + 64 * 264 * 4);
    const int hb = F.tid >> 8, tt = F.tid & 255, c0 = 2 * tt;
    f32x2 cw[CW];
#pragma unroll
    for (int w = 0; w < CW; ++w) cw[w] = *(const f32x2*)(p.in[19] + w * DCONV + c0);
    const f32x2 cb = *(const f32x2*)(p.in[20] + c0), lg = *(const f32x2*)(p.in[21] + c0), lb = *(const f32x2*)(p.in[22] + c0);
    unsigned wp0[16], wp1[16];
#pragma unroll
    for (int m = 0; m < 16; ++m) { wp0[m] = cvt_pk_bf16(cw[2 * m].x, (2 * m + 1 < CW) ? cw[2 * m + 1 < CW ? 2 * m + 1 : 0].x : 0.f); wp1[m] = cvt_pk_bf16(cw[2 * m].y, (2 * m + 1 < CW) ? cw[2 * m + 1 < CW ? 2 * m + 1 : 0].y : 0.f); }
    unsigned wv[46];
#define CONV_LOAD(unit_) { const int row0_ = (unit_) * 32 + hb * 16; \
        if ((unit_) < NP / 32) { const int t0_ = row0_ & (SEQ - 1); \
            _Pragma("unroll") for (int i = 0; i < 46; ++i) { const bool ok_ = (t0_ - 30 + i) >= 0; const int rr_ = ok_ ? (row0_ - 30 + i) : row0_; \
                const unsigned w_ = *(const unsigned*)(Vb + (size_t)rr_ * DCONV + c0); wv[i] = ok_ ? w_ : 0u; } } \
        else { const int js_ = (row0_ - NP) >> 4; \
            _Pragma("unroll") for (int i = 0; i < 30; ++i) { const f32x2 h_ = *(const f32x2*)(p.in[4] + (size_t)(js_ * 30 + i) * DCONV + c0); wv[i] = cvt_pk_bf16(h_.x, h_.y); } \
            _Pragma("unroll") for (int i = 30; i < 46; ++i) wv[i] = *(const unsigned*)(Vb + (size_t)(row0_ - 30 + i) * DCONV + c0); } }
    if ((int)blockIdx.x < R / 32) CONV_LOAD((int)blockIdx.x)
    for (int unit = blockIdx.x; unit < R / 32; unit += F.G) {
        const int row0 = unit * 32 + hb * 16;
        unsigned P0[46], P1[46];
#pragma unroll
        for (int i = 0; i < 45; ++i) { P0[i] = __builtin_amdgcn_perm(wv[i + 1], wv[i], 0x05040100u); P1[i] = __builtin_amdgcn_perm(wv[i + 1], wv[i], 0x07060302u); }
        P0[45] = wv[45] & 0xffffu; P1[45] = wv[45] >> 16;
        f32x2 acc[16];
#pragma unroll
        for (int k = 0; k < 16; ++k) {
            float a0 = cb.x, a1 = cb.y;
#pragma unroll
            for (int m = 0; m < 16; ++m) {
                a0 = __builtin_amdgcn_fdot2_f32_bf16(__builtin_bit_cast(bf16v2, P0[k + 2 * m]), __builtin_bit_cast(bf16v2, wp0[m]), a0, false);
                a1 = __builtin_amdgcn_fdot2_f32_bf16(__builtin_bit_cast(bf16v2, P1[k + 2 * m]), __builtin_bit_cast(bf16v2, wp1[m]), a1, false);
            }
            acc[k] = (f32x2){a0, a1};
        }
        if (unit + F.G < R / 32) CONV_LOAD(unit + F.G)
        if constexpr (PMODE != 0) { float sk = 0.f;
#pragma unroll
            for (int k = 0; k < 16; ++k) sk += acc[k].x + acc[k].y;
            if (sk == 12345.678f) Cat[0] = 0; continue; }
        LDS_BARRIER();
#pragma unroll
        for (int k = 0; k < 16; ++k) { red[((hb * 32 + k) * 8 + (tt >> 5)) * 33 + (tt & 31)] = acc[k].x + acc[k].y; red[((hb * 32 + 16 + k) * 8 + (tt >> 5)) * 33 + (tt & 31)] = acc[k].x * acc[k].x + acc[k].y * acc[k].y; }
        LDS_BARRIER();
        { const int pair = F.tid >> 3, oct = F.tid & 7; float s = 0.f;
#pragma unroll
          for (int k = 0; k < 32; ++k) s += red[(pair * 8 + oct) * 33 + k];
          s += __shfl_xor(s, 1); s += __shfl_xor(s, 2); s += __shfl_xor(s, 4);
          LDS_BARRIER();
          if (oct == 0) red[pair] = s; }
        LDS_BARRIER();
        if (F.tid < 32) { const int h2 = F.tid >> 4, k = F.tid & 15; const float mean = red[h2 * 32 + k] * (1.f / DCONV), ex2 = red[h2 * 32 + 16 + k] * (1.f / DCONV);
            stat[F.tid] = (f32x2){mean, __builtin_amdgcn_rsqf(fmaxf(ex2 - mean * mean, 0.f) + LN_EPS)}; }
        LDS_BARRIER();
#pragma unroll
        for (int k = 0; k < 16; ++k) { const f32x2 st = stat[hb * 16 + k];
            const float a = (acc[k].x - st.x) * st.y * lg.x + lb.x, b = (acc[k].y - st.x) * st.y * lg.y + lb.y;
            *(unsigned*)(Cat + (size_t)(row0 + k) * DM + DSSM + c0) = cvt_pk_bf16(a * sigmoidf_(a), b * sigmoidf_(b)); }
    }
#undef CONV_LOAD
    __syncthreads();
}


__device__ __forceinline__ void colsum_finalize(const Params& p, const Frame& F0) {
    const Frame F = fresh(F0);
    const float* csp = (const float*)(p.ws + WS_CSP); float* csf = (float*)(p.ws + WS_CSF);
    for (int i = F.vcu * 512 + F.tid; i < 2 * DM + 2 * DFF; i += F.G * 512) {
        const float* src; int N, n; float add = 0.f;
        if (i < DM) { src = csp; N = DM; n = i; } else if (i < 2 * DM) { src = csp + 16 * DM; N = DM; n = i - DM; }
        else if (i < 2 * DM + DFF) { src = csp + 32 * DM; N = DFF; n = i - 2 * DM; } else { src = csp + 32 * DM + 16 * DFF; N = DFF; n = i - 2 * DM - DFF; add = p.in[33][n]; }
        float s = 0.f;
#pragma unroll
        for (int kb = 0; kb < 16; ++kb) s += src[(size_t)kb * N + n];
        csf[i] = s + add;
    }
}

__device__ __forceinline__ void ln_bf16_phase(const Frame& F0, const bf16_t* T, bf16_t* X, const float* gam, const float* bet) {
    const Frame F = fresh(F0);
    const int gw = F.vcu * 8 + F.wave, NGW = F.G * 8;
    f32x4 g4[4], b4[4];
#pragma unroll
    for (int h = 0; h < 2; ++h) { g4[2 * h] = *(const f32x4*)(gam + h * 512 + F.lane * 8); g4[2 * h + 1] = *(const f32x4*)(gam + h * 512 + F.lane * 8 + 4);
        b4[2 * h] = *(const f32x4*)(bet + h * 512 + F.lane * 8); b4[2 * h + 1] = *(const f32x4*)(bet + h * 512 + F.lane * 8 + 4); }
    for (int m = gw; m < R; m += NGW) {
        f32x4 v[4]; float s = 0.f;
#pragma unroll
        for (int h = 0; h < 2; ++h) { pg8::unpack8(*(const u32x4*)(T + (size_t)m * DM + h * 512 + F.lane * 8), v[2 * h], v[2 * h + 1]); }
#pragma unroll
        for (int q = 0; q < 4; ++q) s += (v[q][0] + v[q][1]) + (v[q][2] + v[q][3]);
        const float mean = wave_sum(s) * (1.f / DM); float s2 = 0.f;
#pragma unroll
        for (int q = 0; q < 4; ++q) { v[q] = v[q] - mean; s2 += (v[q][0] * v[q][0] + v[q][1] * v[q][1]) + (v[q][2] * v[q][2] + v[q][3] * v[q][3]); }
        const float rstd = __builtin_amdgcn_rsqf(wave_sum(s2) * (1.f / DM) + LN_EPS);
#pragma unroll
        for (int h = 0; h < 2; ++h) *(u32x4*)(X + (size_t)m * DM + h * 512 + F.lane * 8) = pg8::pack8(v[2 * h] * rstd * g4[2 * h] + b4[2 * h], v[2 * h + 1] * rstd * g4[2 * h + 1] + b4[2 * h + 1]);
    }
}
__device__ __forceinline__ void ln_f32_inplace_phase(const Frame& F0, float* Y, const float* gam, const float* bet) {
    const Frame F = fresh(F0);
    const int gw = F.vcu * 8 + F.wave, NGW = F.G * 8;
    f32x4 g4[4], b4[4];
#pragma unroll
    for (int q = 0; q < 4; ++q) { g4[q] = *(const f32x4*)(gam + q * 256 + F.lane * 4); b4[q] = *(const f32x4*)(bet + q * 256 + F.lane * 4); }
    for (int m0 = gw; m0 < R; m0 += 2 * NGW) {
        const int m1 = m0 + NGW; const bool ok1 = m1 < R; const int mm1 = ok1 ? m1 : m0;
        f32x4 v[2][4];
#pragma unroll
        for (int q = 0; q < 4; ++q) { v[0][q] = *(const f32x4*)(Y + (size_t)m0 * DM + q * 256 + F.lane * 4); v[1][q] = *(const f32x4*)(Y + (size_t)mm1 * DM + q * 256 + F.lane * 4); }
#pragma unroll
        for (int h = 0; h < 2; ++h) {
            float s = 0.f;
#pragma unroll
            for (int q = 0; q < 4; ++q) s += (v[h][q][0] + v[h][q][1]) + (v[h][q][2] + v[h][q][3]);
            const float mean = wave_sum(s) * (1.f / DM); float s2 = 0.f;
#pragma unroll
            for (int q = 0; q < 4; ++q) { v[h][q] = v[h][q] - mean; s2 += (v[h][q][0] * v[h][q][0] + v[h][q][1] * v[h][q][1]) + (v[h][q][2] * v[h][q][2] + v[h][q][3] * v[h][q][3]); }
            const float rstd = __builtin_amdgcn_rsqf(wave_sum(s2) * (1.f / DM) + LN_EPS);
            if (h == 0 || ok1) {
                float* yo = Y + (size_t)(h == 0 ? m0 : m1) * DM;
#pragma unroll
                for (int q = 0; q < 4; ++q) __builtin_nontemporal_store(v[h][q] * rstd * g4[q] + b4[q], (f32x4*)(yo + q * 256 + F.lane * 4));
            }
        }
    }
}

#define XB_TMO      128
#define XB_XCNT(j)  (256  + 64 * (j))
#define XB_XSUB(j)  (1280 + 64 * (j))
#define XB_XGEN(j)  (2304 + 64 * (j))
#define XB_TOP      3328
#define XB_TOPGEN   3392
#define XCD_BAR_WORDS 3456
#define XB_SPIN_CAP (1u << 18)
__device__ __forceinline__ unsigned xb_ld(unsigned* p)              { return __hip_atomic_load(p, __ATOMIC_RELAXED, __HIP_MEMORY_SCOPE_AGENT); }
__device__ __forceinline__ unsigned xb_add(unsigned* p, unsigned v) { return __hip_atomic_fetch_add(p, v, __ATOMIC_RELAXED, __HIP_MEMORY_SCOPE_AGENT); }
__device__ __forceinline__ unsigned xb_xcc_id() { return (unsigned)__builtin_amdgcn_s_getreg((3 << 11) | 20) & 0xFu; }
#define XB_SPIN(cond, bar) do { unsigned _sp = 0; while (cond) { __builtin_amdgcn_s_sleep(1); \
    if ((++_sp & 255u) == 0u) { if (xb_ld(&(bar)[XB_TMO])) break; if (_sp > XB_SPIN_CAP) { atomicAdd(&(bar)[XB_TMO], 1u); break; } } } } while (0)
struct XcdBarrier { unsigned* bar; unsigned x; volatile LAS unsigned* st; };
__device__ __forceinline__ XcdBarrier xcd_barrier_post(unsigned* bar, volatile LAS unsigned* st) {
    XcdBarrier b; b.bar = bar; b.x = xb_xcc_id(); b.st = st;
    if (threadIdx.x == 0) (void)xb_add(&bar[XB_XCNT(b.x)], 1u);
    return b;
}
__device__ __forceinline__ void xcd_barrier_complete(unsigned* bar, unsigned x, unsigned& nloc, unsigned& nx) {
    const unsigned G = gridDim.x * gridDim.y * gridDim.z;
    unsigned sum, cnt, mine, sp = 0u;
    for (;;) {
        sum = 0u; cnt = 0u; mine = 0u;
#pragma unroll
        for (unsigned j = 0; j < 16; ++j) { const unsigned c = xb_ld(&bar[XB_XCNT(j)]); sum += c; cnt += (c > 0u) ? 1u : 0u; mine = (j == x) ? c : mine; }
        if (sum == G) break;
        __builtin_amdgcn_s_sleep(1);
        if ((++sp & 255u) == 0u) { if (xb_ld(&bar[XB_TMO])) break; if (sp > XB_SPIN_CAP) { atomicAdd(&bar[XB_TMO], 1u); break; } }
    }
    nloc = mine > 0u ? mine : 1u; nx = cnt > 0u ? cnt : 1u;
}
__device__ __forceinline__ void xcd_barrier(const XcdBarrier& b) {
    asm volatile("s_waitcnt vmcnt(0)" ::: "memory");
    __syncthreads();
    if (threadIdx.x == 0) {
        unsigned* bar = b.bar;
        __builtin_amdgcn_s_waitcnt(0);
        unsigned nloc = b.st[0], nx = b.st[1];
        if (nloc == 0u) { xcd_barrier_complete(bar, b.x, nloc, nx); b.st[0] = nloc; b.st[1] = nx; }
        const unsigned old = xb_add(&bar[XB_XSUB(b.x)], 1u);
        const unsigned gen = old / nloc;
        if (old + 1u == (gen + 1u) * nloc) {
            __builtin_amdgcn_fence(__ATOMIC_RELEASE, "agent");
            asm volatile("s_waitcnt vmcnt(0)" ::: "memory");
            const unsigned og = xb_add(&bar[XB_TOP], 1u);
            const unsigned tg = og / nx;
            if (og + 1u == (tg + 1u) * nx) xb_add(&bar[XB_TOPGEN], 1u);
            else XB_SPIN(xb_ld(&bar[XB_TOPGEN]) == tg, bar);
            __builtin_amdgcn_fence(__ATOMIC_ACQUIRE, "agent");
            xb_add(&bar[XB_XGEN(b.x)], 1u);
            asm volatile("s_waitcnt vmcnt(0)" ::: "memory");
        } else {
            XB_SPIN(xb_ld(&bar[XB_XGEN(b.x)]) == gen, bar);
            __builtin_amdgcn_fence(__ATOMIC_ACQUIRE, "agent");
            asm volatile("s_waitcnt vmcnt(0)" ::: "memory");
        }
    }
    __syncthreads();
}

__global__ void __launch_bounds__(512, 2) fwd_megakernel(Params p) {
    extern __shared__ __attribute__((aligned(16))) unsigned char lds_raw[];
    cg::grid_group grid = cg::this_grid();
    Frame F; F.lds = (LAS unsigned char*)lds_raw; F.tid = threadIdx.x; F.lane = F.tid & 63; F.wave = __builtin_amdgcn_readfirstlane(F.tid >> 6);
    F.G = gridDim.x; { const int bx = blockIdx.x; F.vcu = (F.G % 8 == 0) ? (bx % 8) * (F.G / 8) + bx / 8 : bx; }
    const int c = blockIdx.x, G = F.G;
    unsigned char* ws = p.ws;
    bf16_t* Xb = (bf16_t*)(ws + WS_XB); bf16_t* Ub = (bf16_t*)(ws + WS_UB); bf16_t* Vb = (bf16_t*)(ws + WS_VB); bf16_t* Zb = (bf16_t*)(ws + WS_ZB); bf16_t* Cat = (bf16_t*)(ws + WS_CAT);
    bf16_t* T1 = (bf16_t*)(ws + WS_T1); f32x2* ST1 = (f32x2*)(ws + WS_ST1); f32x2* ST2 = (f32x2*)(ws + WS_ST2); const float* CSF = (const float*)(ws + WS_CSF); bf16_t* Qb = (bf16_t*)(ws + WS_QB); bf16_t* Pb = (bf16_t*)(ws + WS_PB); bf16_t* Ob = (bf16_t*)(ws + WS_OB);
    bf16_t* T2 = (bf16_t*)(ws + WS_T2); bf16_t* Hb = (bf16_t*)(ws + WS_HB);
    bf16_t* Kb = (bf16_t*)(ws + WS_KB); bf16_t* Vt = (bf16_t*)(ws + WS_VT); bf16_t* Mb = (bf16_t*)(ws + WS_MEMB);
    using namespace pg8;
    { volatile LAS unsigned* st0 = (volatile LAS unsigned*)(F.lds + RING_BYTES + 12288); if (F.tid < 4) st0[F.tid] = 0u; }
    __syncthreads();
    const XcdBarrier xbar = xcd_barrier_post((unsigned*)ws, (volatile LAS unsigned*)(F.lds + RING_BYTES + 12288));
#define GRID_BAR() xcd_barrier(xbar)

    if constexpr (PHASE_MASK & 1) p0_prologue(p, F);
    if constexpr (PROBE_DUP & 1) p0_prologue(p, F);
    if (p.ws == nullptr) grid.sync();
    GRID_BAR();
    for (int rep = 0; rep < ((PROBE_DUP & 2048) ? 2 : 1); ++rep)
    if constexpr (PHASE_MASK & 2) { const bf16_t* Win_t = (const bf16_t*)(ws + WS_WIN); const bf16_t* Wkv_t = (const bf16_t*)(ws + WS_WKV);
      RegSched S; S.init(Xb, DM, Win_t, DM, NP, DIN, G, c); EpiWin E{Ub, Vb, p.out};
      gemm_phase<EpiWin, RegSched, true>(F.lds, GemmDesc{DM, DM, DM}, S, E);
      small_gemm<EpiWin, false>(F.lds, Xb + (size_t)NP * DM, DM, Win_t, DM, DM, 4, 8, NP, 0, E, G, c);
      small_gemm<EpiWin, true>(F.lds, Xb + (size_t)NP * DM, DM, Win_t, DM, DM, 4, 16, NP, 0, E, G, (c + G - 32) % G);
      { EpiKv E2{Kb, Vt, p.out, 0, nullptr}; small_gemm<EpiKv, false>(F.lds, Mb, DM, Wkv_t, DM, DM, 8, 16, 0, 0, E2, G, (c + G - 96) % G); }
      { EpiKv E2{Kb, Vt, p.out, 1, (bf16_t*)(ws + WS_V16)}; small_gemm<EpiKv, false>(F.lds, Mb, DM, Wkv_t + (size_t)DM * DM, DM, DM, 8, 16, 0, 0, E2, G, (c + G - 224) % G); }
        }
    GRID_BAR();
    colsum_finalize(p, F);
    if constexpr (PHASE_MASK & 4) ssm_phase<false>(p, F);
    if constexpr (PHASE_MASK & 8) conv_phase<0>(p, F);
    if constexpr (PHASE_MASK & 16) ssm_phase<true, 1>(p, F);
    {
        const bf16_t* Wo_t = (const bf16_t*)(ws + WS_WO); const bf16_t* V16 = (const bf16_t*)(ws + WS_V16); bf16_t* NT = (bf16_t*)(ws + WS_NT);
#pragma unroll 1
        for (int q = 0; q < 8; ++q) { const int b = q >> 2, h = q & 3;
            EpiGen<0> E{NT + (size_t)b * DM * DM, DM, nullptr, 0, nullptr, 1.f};
            small_gemm<EpiGen<0>, false>(F.lds, Wo_t + h * 256, DM, V16 + (size_t)(b * NMEM) * DM + h * 256, DM, HD, 16, 4, 0, h * 256, E, G, (c + G - (64 * q) % G) % G); }
    }
    if constexpr (PROBE_DUP & 2) ssm_phase<false>(p, F);
    if constexpr (PROBE_DUP & 4) conv_phase<0>(p, F);
    if constexpr (PROBE_DUP & 32) conv_phase<1>(p, F);
    if constexpr (PROBE_DUP & 64) conv_phase<2>(p, F);
    GRID_BAR();
    if constexpr (PHASE_MASK & 16) ssm_phase<true>(p, F);
    if constexpr (PROBE_DUP & 8) ssm_phase<true>(p, F);
    GRID_BAR();
    if constexpr (PHASE_MASK & 32) { RegSched S; S.init(Zb, DSSM, (const bf16_t*)(ws + WS_GLU), DSSM, NP, DSSM, G, c); EpiGen<4> E{Cat, DM, Zb, DSSM, p.in[18], 1.f};
      gemm_phase<EpiGen<4>, RegSched, true>(F.lds, GemmDesc{DSSM, DSSM, DSSM}, S, E);
      small_gemm<EpiGen<4>, false>(F.lds, Zb + (size_t)NP * DSSM, DSSM, (const bf16_t*)(ws + WS_GLU), DSSM, DSSM, 4, 8, NP, 0, E, G, c); }
    GRID_BAR();
    if constexpr (PHASE_MASK & 64) { RegSched S; S.init(Cat, DM, (const bf16_t*)(ws + WS_WOUT), DM, NP, DM, G, c); EpiLn<1> E{T1, DM, Xb, nullptr, ST1, nullptr, nullptr, nullptr, 1.f, 0};
      gemm_phase<EpiLn<1>, RegSched, true>(F.lds, GemmDesc{DM, DM, DM}, S, E);
      small_gemm<EpiLn<1>, false>(F.lds, Cat + (size_t)NP * DM, DM, (const bf16_t*)(ws + WS_WOUT), DM, DM, 4, 16, NP, 0, E, G, c); }
    GRID_BAR();
    if constexpr (PHASE_MASK & 256) { RegSched S; S.init(T1, DM, (const bf16_t*)(ws + WS_WQ), DM, NP, DM, G, c); EpiLn<2> E{Qb, DM, nullptr, ST1, nullptr, CSF, CSF + DM, nullptr, 0.0625f, 0}; E.prep(S, F.lds + RING_BYTES);
      gemm_phase<EpiLn<2>, RegSched, true>(F.lds, GemmDesc{DM, DM, DM}, S, E);
      small_gemm<EpiLn<2>, false>(F.lds, T1 + (size_t)NP * DM, DM, (const bf16_t*)(ws + WS_WQ), DM, DM, 4, 16, NP, 0, E, G, c); }
    GRID_BAR();
    for (int rep = 0; rep < ((PROBE_DUP & 1024) ? 2 : 1); ++rep)
    if constexpr (PHASE_MASK & 512) { AttSched S{Qb, Kb, 0, G, c, 0}; EpiSoftmax E{Pb};
      gemm_phase<EpiSoftmax, AttSched, true>(F.lds, GemmDesc{HD, DM, DM}, S, E); }
    asm volatile("s_waitcnt vmcnt(0)" ::: "memory"); __syncthreads();
    if (F.tid == 0) { __builtin_amdgcn_fence(__ATOMIC_ACQUIRE, "agent"); asm volatile("s_waitcnt vmcnt(0)" ::: "memory"); }
    __syncthreads();
    if constexpr (PHASE_MASK & 1024) { AttSched S{Pb, Vt, 1, G, c, 512}; EpiGen<0> E{Ob, DM, nullptr, 0, nullptr, 1.f};
      gemm_phase<EpiGen<0>, AttSched, true>(F.lds, GemmDesc{NMEM, DM, NMEM}, S, E); }
    GRID_BAR();
    if constexpr (PHASE_MASK & 2048) { BatchSched S; S.init(Pb, DM, (const bf16_t*)(ws + WS_NT), DM, NP, DM, G, c); EpiLn<3> E{T2, DM, T1, ST1, ST2, p.in[24], p.in[25], nullptr, 1.f, 0}; E.prep(S, F.lds + RING_BYTES);
      gemm_phase<EpiLn<3>, BatchSched, true>(F.lds, GemmDesc{DM, DM, DM}, S, E);
      small_gemm<EpiLn<3>, false>(F.lds, Ob + (size_t)NP * DM, DM, (const bf16_t*)(ws + WS_WO), DM, DM, 4, 16, NP, 0, E, G, c); }
    GRID_BAR();
    if constexpr (PHASE_MASK & 4096) { RegSched S; S.init(T2, DM, (const bf16_t*)(ws + WS_W1), DM, NP, DFF, G, c); EpiLn<4> E{Hb, DFF, nullptr, ST2, nullptr, CSF + 2 * DM, CSF + 2 * DM + DFF, nullptr, 1.f, 0}; E.prep(S, F.lds + RING_BYTES);
      gemm_phase<EpiLn<4>, RegSched, true>(F.lds, GemmDesc{DM, DM, DM}, S, E);
      small_gemm<EpiLn<4>, false>(F.lds, T2 + (size_t)NP * DM, DM, (const bf16_t*)(ws + WS_W1), DM, DM, 4, 64, NP, 0, E, G, c); }
    GRID_BAR();
    if constexpr (PHASE_MASK & 8192) { RegSched S; S.init(Hb, DFF, (const bf16_t*)(ws + WS_W2), DFF, NP, DM, G, c); EpiLn<5> E{p.out, DM, T2, ST2, nullptr, p.in[30], p.in[31], p.in[35], 1.f, 0}; E.prep(S, F.lds + RING_BYTES);
      gemm_phase<EpiLn<5>, RegSched, true>(F.lds, GemmDesc{DFF, DFF, DFF}, S, E);
      small_gemm<EpiLn<5>, false>(F.lds, Hb + (size_t)NP * DFF, DFF, (const bf16_t*)(ws + WS_W2), DFF, DFF, 4, 16, NP, 0, E, G, c); }
    GRID_BAR();
    if constexpr (PROBE_DUP & 4096) { GRID_BAR(); GRID_BAR(); GRID_BAR(); GRID_BAR(); }
    if constexpr (PHASE_MASK & 16384) ln_f32_inplace_phase(F, p.out, p.in[36], p.in[37]);
}

extern "C" void kernel_launch(void* const* d_in, const int* in_sizes, int n_in, void* d_out, int out_size, void* d_ws, size_t ws_size, hipStream_t stream) {
    static int grid = 0;
    if (grid == 0) {
        if (n_in != 38 || ws_size < WS_END) { fprintf(stderr, "kernel_launch: unexpected n_in %d / ws_size %zu (need %zu)\n", n_in, ws_size, (size_t)WS_END); grid = -1; return; }
        int dev = 0, cus = 0, per_cu = 0;
        hipGetDevice(&dev); hipDeviceGetAttribute(&cus, hipDeviceAttributeMultiprocessorCount, dev);
        hipFuncSetAttribute((const void*)fwd_megakernel, hipFuncAttributeMaxDynamicSharedMemorySize, LDS_BYTES);
        hipOccupancyMaxActiveBlocksPerMultiprocessor(&per_cu, (const void*)fwd_megakernel, 512, LDS_BYTES);
        if (per_cu < 1) { fprintf(stderr, "kernel_launch: occupancy query says %d blocks per CU\n", per_cu); per_cu = 1; }
        grid = cus;
        if (grid > 256) grid = 256;
    }
    if (grid < 0) return;
    Params p{};
    for (int i = 0; i < 38; ++i) p.in[i] = (const float*)d_in[i];
    p.out = (float*)d_out; p.ws = (unsigned char*)d_ws;
    hipMemsetAsync(d_ws, 0, 16384, stream);
    void* args[] = {&p};
    hipError_t e = hipLaunchCooperativeKernel((const void*)fwd_megakernel, dim3(grid), dim3(512), args, LDS_BYTES, stream);
    if (e != hipSuccess) fprintf(stderr, "cooperative launch failed: %s (grid %d)\n", hipGetErrorString(e), grid);
}
```

```cpp
#include <hip/hip_runtime.h>
#include <hip/hip_cooperative_groups.h>
#include <cstdio>
#include <cstdint>
namespace cg = cooperative_groups;

#define LAS __attribute__((address_space(3)))
typedef unsigned short bf16_t;
typedef short bf16x8 __attribute__((ext_vector_type(8)));
typedef float f32x4 __attribute__((ext_vector_type(4)));
typedef float f32x2 __attribute__((ext_vector_type(2)));
typedef unsigned u32x4 __attribute__((ext_vector_type(4)));
typedef unsigned u32x2 __attribute__((ext_vector_type(2)));
typedef __bf16 bf16v2 __attribute__((ext_vector_type(2)));

constexpr int DM = 1024, SEQ = 16384, NB = 2, NP = NB * SEQ, NSB = 16, NST = 16, NS = NSB * NST, R = NP + NS, RPAD = R + 256;
constexpr int DSSM = 512, DCONV = 512, DIN = 1536, DFF = 4096, NMEM = 256, NH = 4, HD = 256, NG = 32, NSTATE = 64, CW = 31;
constexpr float ALPHA = 1.189207115002721f;
constexpr float LN_EPS = 1e-5f;
constexpr size_t O_Y = 0, O_SRP = (size_t)R * DM, O_SIP = O_SRP + 4096, O_CVP = O_SIP + 4096, O_MKP = O_CVP + 30720, O_MVP = O_MKP + 524288,
                 O_SRS = O_MVP + 524288, O_SIS = O_SRS + 32768, O_CVS = O_SIS + 32768;
constexpr size_t MiB = 1u << 20;
constexpr size_t WS_WIN = 1 * MiB, WS_GLU = 4 * MiB, WS_WOUT = 5 * MiB, WS_WQ = 7 * MiB, WS_WKV = 9 * MiB, WS_WO = 13 * MiB, WS_W1 = 15 * MiB, WS_W2 = 23 * MiB,
                 WS_SSMW = 460 * MiB  , WS_M1 = 33 * MiB  , WS_WST = 34 * MiB  , WS_MEMB = 35 * MiB  ,
                 WS_KB = 36 * MiB  , WS_VT = 45 * MiB  ;
constexpr size_t WS_S1 = 56 * MiB, WS_S2 = 122 * MiB, WS_BIG = 188 * MiB;
constexpr size_t WS_T1 = WS_S1, WS_T2 = WS_S2;
constexpr size_t WS_CSP = 54 * MiB  , WS_CSF = 55 * MiB  ;
constexpr size_t WS_ST1 = 448 * MiB, WS_ST2 = 453 * MiB;
constexpr size_t WS_XB = WS_BIG, WS_UB = WS_BIG + 66 * MiB, WS_VB = WS_BIG + 99 * MiB, WS_ZB = WS_BIG + 132 * MiB, WS_CAT = WS_BIG + 165 * MiB;
constexpr size_t WS_QB = WS_BIG, WS_PB = WS_BIG + 66 * MiB, WS_OB = WS_BIG + 132 * MiB, WS_HB = WS_BIG;
constexpr size_t WS_V16 = 464 * MiB  , WS_NT = 465 * MiB  ;
constexpr size_t WS_END = 470 * MiB;
constexpr int SSM_NFRAG = 96, SSM_FRAG_ELEMS = SSM_NFRAG * 512;
constexpr int SSM_M1_OFF = SSM_FRAG_ELEMS * 2;

#ifndef PROBE_DUP
#define PROBE_DUP 0
#endif
#ifndef PHASE_MASK
#define PHASE_MASK 0xFFFF
#endif
constexpr int LDS_BYTES = 147456;
constexpr int RING_BYTES = 131072;

struct Params {
    const float* in[38];
    float* out;
    unsigned char* ws;
};

__device__ __forceinline__ unsigned cvt_pk_bf16(float lo, float hi) { unsigned r; asm("v_cvt_pk_bf16_f32 %0, %1, %2" : "=v"(r) : "v"(lo), "v"(hi)); return r; }
__device__ __forceinline__ float bf_lo(unsigned w) { return __uint_as_float(w << 16); }
__device__ __forceinline__ float bf_hi(unsigned w) { return __uint_as_float(w & 0xffff0000u); }
__device__ __forceinline__ unsigned short f2bf(float f) { return (unsigned short)(cvt_pk_bf16(f, 0.f) & 0xffffu); }
__device__ __forceinline__ float sigmoidf_(float x) { return __builtin_amdgcn_rcpf(1.f + __builtin_amdgcn_exp2f(-1.4426950408889634f * x)); }
__device__ __forceinline__ float gelu_tanh(float x) {
    const float t = x * x, u = x * (-2.3022082f - 0.10294324f * t); return x * __builtin_amdgcn_rcpf(1.f + __builtin_amdgcn_exp2f(u)); }
template <int CTRL> __device__ __forceinline__ float dppf(float v) {
    return __builtin_bit_cast(float, __builtin_amdgcn_update_dpp(0, __builtin_bit_cast(int, v), CTRL, 0xf, 0xf, true));
}
#define DPP_SHR(n) (0x110 + (n))
#define DPP_ROR(n) (0x120 + (n))
#define LDS_BARRIER() do { asm volatile("s_waitcnt lgkmcnt(0)" ::: "memory"); __builtin_amdgcn_s_barrier(); asm volatile("" ::: "memory"); } while (0)
__device__ __forceinline__ float wave_sum(float v) {
#pragma unroll
    for (int o = 1; o < 64; o <<= 1) v += __shfl_xor(v, o);
    return v;
}

namespace pg8 {
constexpr int BM = 256, BK = 64, HALF = 128, HTB = HALF * BK * 2, STAGE_BYTES = 8 * HTB;
__host__ __device__ __forceinline__ int lds_byte(int r, int c) { const int st = (r >> 4) * 2 + (c >> 5), rr = r & 15, cc = c & 31, ob = rr * 64 + cc * 2; return st * 1024 + (ob ^ (((ob >> 9) & 1) << 5)); }
__host__ __device__ __forceinline__ void stage_rc(int b, int& Rr, int& C) { const int st = b / 1024, sb = b % 1024, swz = sb ^ (((sb >> 9) & 1) << 5); Rr = (st >> 1) * 16 + swz / 64; C = (st & 1) * 32 + (swz % 64) / 2; }
__host__ __device__ __forceinline__ int perm32(int rho) { const int n = rho >> 4, i = rho & 15; return 8 * (i >> 2) + 4 * n + (i & 3); }

struct Unit { int row0, col0, nvalid, aux; };
struct GemmDesc { int K, lda, ldb; };

template <class Epi, class Sched, bool ALIGN_EPI>
__device__ __forceinline__ void gemm_phase(LAS unsigned char* lds, const GemmDesc g, const Sched& S, const Epi& E) {
    int tid = threadIdx.x; asm volatile("" : "+v"(tid));
    const int wid = __builtin_amdgcn_readfirstlane(tid >> 6), lane = tid & 63, wr = wid >> 2, wc = wid & 3, fr = lane & 15, fq = lane >> 4;
    const int K = g.K, nt = K / BK;
    unsigned voffA[2], voffB[2];
#pragma unroll
    for (int i = 0; i < 2; ++i) { int Rr, C; stage_rc(tid * 16 + i * 8192, Rr, C); const int Rb = Epi::PERM ? ((Rr & ~31) + perm32(Rr & 31)) : Rr;
        voffA[i] = (unsigned)(Rr * g.lda + C) * 2u; voffB[i] = (unsigned)(Rb * g.ldb + C) * 2u; }
    const size_t kstep = (size_t)(BK * 2);
    const size_t hstepA = (size_t)HALF * g.lda * 2, hstepB = (size_t)HALF * g.ldb * 2;
    const unsigned ldsw = (unsigned)wid * 1024u;
    const int aoff = lds_byte(wr * 64 + fr, fq * 8), boff = lds_byte(wc * 32 + fr, fq * 8);
#define PG8_SA(b, h) (((b) * 2 + (h)) * HTB)
#define PG8_SB(b, h) ((4 + (b) * 2 + (h)) * HTB)
#define PG8_STAGE(bufoff, gbase, voff) do { _Pragma("unroll") for (int _i = 0; _i < 2; ++_i) \
        __builtin_amdgcn_global_load_lds((const unsigned*)((const char*)(gbase) + (voff)[_i]), (LAS unsigned*)(lds + (bufoff) + ldsw + _i * 8192), 16, 0, 0); } while (0)
#define PG8_LDA(dst, b, h) do { _Pragma("unroll") for (int m = 0; m < 4; ++m) _Pragma("unroll") for (int k = 0; k < 2; ++k) dst[m][k] = *(const LAS bf16x8*)(lds + PG8_SA(b, h) + aoff + m * 2048 + k * 1024); } while (0)
#define PG8_LDB(dst, b, h) do { _Pragma("unroll") for (int n = 0; n < 2; ++n) _Pragma("unroll") for (int k = 0; k < 2; ++k) dst[n][k] = *(const LAS bf16x8*)(lds + PG8_SB(b, h) + boff + n * 2048 + k * 1024); } while (0)
#define PG8_MMA(ai, bj, At, Bt) do { __builtin_amdgcn_s_setprio(3); _Pragma("unroll") for (int m = 0; m < 4; ++m) _Pragma("unroll") for (int n = 0; n < 2; ++n) _Pragma("unroll") for (int k = 0; k < 2; ++k) \
        acc[ai][bj][m][n] = __builtin_amdgcn_mfma_f32_16x16x32_bf16(Bt[n][k], At[m][k], acc[ai][bj][m][n], 0, 0, 0); __builtin_amdgcn_s_setprio(0); } while (0)
#define PG8_WAIT_V(n) asm volatile("s_waitcnt vmcnt(" #n ")" ::: "memory")
#define PG8_WAIT_L(n) asm volatile("s_waitcnt lgkmcnt(" #n ")" ::: "memory")
#define PG8_BAR __builtin_amdgcn_s_barrier()
#define PG8_SCHED __builtin_amdgcn_sched_barrier(0)
    Unit cur, nxt; int ui = 0;
    if (!S.next(0, cur)) return;
    f32x4 acc[2][2][4][2];
#pragma unroll
    for (int a = 0; a < 2; ++a)
#pragma unroll
        for (int b = 0; b < 2; ++b)
#pragma unroll
            for (int m = 0; m < 4; ++m)
#pragma unroll
                for (int n = 0; n < 2; ++n) acc[a][b][m][n] = (f32x4){0.f, 0.f, 0.f, 0.f};
    bf16x8 At[4][2], B0[2][2], B1[2][2];
    const char* cA = S.aptr(cur); const char* cB = S.bptr(cur);
    PG8_STAGE(PG8_SB(0, 0), cB, voffB); PG8_STAGE(PG8_SB(0, 1), cB + hstepB, voffB); PG8_STAGE(PG8_SA(0, 0), cA, voffA); PG8_STAGE(PG8_SA(0, 1), cA + hstepA, voffA);
    if (wr == 1) PG8_BAR;
    PG8_WAIT_V(2); PG8_BAR;
    PG8_STAGE(PG8_SB(1, 0), cB + kstep, voffB); PG8_STAGE(PG8_SA(1, 0), cA + kstep, voffA); PG8_STAGE(PG8_SB(1, 1), cB + hstepB + kstep, voffB);
    PG8_WAIT_V(6); PG8_BAR;
    for (;;) {
        const bool has_next = S.next(ui + 1, nxt);
        const char* nA = has_next ? S.aptr(nxt) : cA; const char* nB = has_next ? S.bptr(nxt) : cB;
        for (int t = 0; t < nt; t += 2) {
            const bool last = (t == nt - 2);
            const char* a1 = cA + (size_t)(t + 1) * kstep;
            const char* a2 = last ? nA : cA + (size_t)(t + 2) * kstep; const char* b2 = last ? nB : cB + (size_t)(t + 2) * kstep;
            const char* a3 = a2 + kstep; const char* b3 = b2 + kstep;
            PG8_LDB(B0, 0, 0); PG8_LDB(B1, 0, 1); PG8_SCHED; PG8_LDA(At, 0, 0); PG8_STAGE(PG8_SA(1, 1), a1 + hstepA, voffA);
            PG8_WAIT_V(8); PG8_WAIT_L(0); PG8_BAR; PG8_MMA(0, 0, At, B0); PG8_MMA(0, 1, At, B1); PG8_BAR; PG8_SCHED;
            PG8_LDA(At, 0, 1); PG8_STAGE(PG8_SB(0, 0), b2, voffB); PG8_STAGE(PG8_SB(0, 1), b2 + hstepB, voffB); PG8_STAGE(PG8_SA(0, 0), a2, voffA);
            PG8_WAIT_V(8); PG8_WAIT_L(0); PG8_BAR; PG8_MMA(1, 0, At, B0); PG8_MMA(1, 1, At, B1); PG8_BAR; PG8_SCHED;
            PG8_LDB(B0, 1, 0); PG8_LDB(B1, 1, 1); PG8_SCHED; PG8_LDA(At, 1, 0); PG8_STAGE(PG8_SA(0, 1), a2 + hstepA, voffA);
            PG8_WAIT_V(8); PG8_WAIT_L(0); PG8_BAR; PG8_MMA(0, 0, At, B0); PG8_MMA(0, 1, At, B1); PG8_BAR; PG8_SCHED;
            PG8_LDA(At, 1, 1); PG8_STAGE(PG8_SB(1, 0), b3, voffB); PG8_STAGE(PG8_SB(1, 1), b3 + hstepB, voffB); PG8_STAGE(PG8_SA(1, 0), a3, voffA);
            PG8_WAIT_V(8); PG8_WAIT_L(0); PG8_BAR; PG8_MMA(1, 0, At, B0); PG8_MMA(1, 1, At, B1); PG8_BAR; PG8_SCHED;
        }
        if constexpr (ALIGN_EPI) { if (wr == 0) PG8_BAR; }
        E(acc, cur, wr, wc, fr, fq, lds + STAGE_BYTES);
        if (!has_next) break;
#pragma unroll
        for (int a = 0; a < 2; ++a)
#pragma unroll
            for (int b = 0; b < 2; ++b)
#pragma unroll
                for (int m = 0; m < 4; ++m)
#pragma unroll
                    for (int n = 0; n < 2; ++n) acc[a][b][m][n] = (f32x4){0.f, 0.f, 0.f, 0.f};
        cur = nxt; cA = nA; cB = nB; ++ui;
        if constexpr (ALIGN_EPI) { if (wr == 1) PG8_BAR; }
    }
    PG8_WAIT_V(0);
    if constexpr (!ALIGN_EPI) { if (wr == 0) PG8_BAR; }
    PG8_BAR;
#undef PG8_SA
#undef PG8_SB
#undef PG8_STAGE
#undef PG8_LDA
#undef PG8_LDB
#undef PG8_MMA
#undef PG8_WAIT_V
#undef PG8_WAIT_L
#undef PG8_BAR
#undef PG8_SCHED
}

struct RegSched {
    const bf16_t* A; const bf16_t* B; int lda, ldb, nM, nN, nwg, G, c;
    __device__ void init(const bf16_t* A_, int lda_, const bf16_t* B_, int ldb_, int M, int N, int G_, int c_) { A = A_; B = B_; lda = lda_; ldb = ldb_; nM = M / BM; nN = N / BM; nwg = nM * nN; G = G_; c = c_; }
    __device__ bool next(int i, Unit& u) const {
        const long L = (long)i * G + c; if (L >= nwg) return false;
        int wgid = (int)L; { const int q = nwg / 8, r = nwg % 8, xcd = wgid % 8, off = wgid / 8; wgid = (xcd < r ? xcd * (q + 1) : r * (q + 1) + (xcd - r) * q) + off; }
        const int nig = 8 * nN, gid = wgid / nig, fm = gid * 8, gsz = (nM - fm) < 8 ? (nM - fm) : 8;
        const int pm = fm + ((wgid % nig) % gsz), pn = (wgid % nig) / gsz;
        u.row0 = pm * BM; u.col0 = pn * BM; u.nvalid = BM; u.aux = pn; return true;
    }
    __device__ const char* aptr(const Unit& u) const { return (const char*)(A + (size_t)u.row0 * lda); }
    __device__ const char* bptr(const Unit& u) const { return (const char*)(B + (size_t)u.col0 * ldb); }
};
struct BatchSched : RegSched {
    __device__ const char* bptr(const Unit& u) const { return (const char*)(B + (u.row0 >= SEQ ? (size_t)DM * DM : 0) + (size_t)u.col0 * ldb); }
};
struct AttSched {
    const bf16_t* A; const bf16_t* B; int pv, G, c, skip;
    __device__ bool next(int i, Unit& u) const {
        int L;
        if (skip) L = i * G + c + skip;
        else if (G == 256) { if (c < 64) L = (i == 0) ? c : (i == 1 ? 512 + c : 1 << 20); else L = c + 192 * i; if (c >= 64 && L >= 512) L = 1 << 20; }
        else L = i * G + c;
        if (L >= 512 + 64) return false;
        if (L < 512) { const int pm = L >> 2, h = L & 3; u.row0 = pm * 256; u.col0 = h * 256; u.nvalid = 256; u.aux = pm >> 6; }
        else { const int idx = L - 512, js = idx >> 2, h = idx & 3; u.row0 = NP + NST * js + NST - 256; u.col0 = h * 256; u.nvalid = -NST; u.aux = 2 + js; }
        return true;
    }
    __device__ const char* aptr(const Unit& u) const { return (const char*)(A + (size_t)u.row0 * DM + u.col0); }
    __device__ const char* bptr(const Unit& u) const {
        return (const char*)(pv ? B + (size_t)u.aux * (DM * NMEM) + (size_t)u.col0 * NMEM : B + (size_t)u.aux * (NMEM * DM) + u.col0); }
};

#define EPI_FOR_ROWS for (int ai = 0; ai < 2; ++ai) _Pragma("unroll") for (int m = 0; m < 4; ++m)
__device__ __forceinline__ u32x4 pack8(const f32x4 a, const f32x4 b) { u32x4 w; w.x = cvt_pk_bf16(a[0], a[1]); w.y = cvt_pk_bf16(a[2], a[3]); w.z = cvt_pk_bf16(b[0], b[1]); w.w = cvt_pk_bf16(b[2], b[3]); return w; }
__device__ __forceinline__ void unpack8(const u32x4 w, f32x4& a, f32x4& b) { a = (f32x4){bf_lo(w.x), bf_hi(w.x), bf_lo(w.y), bf_hi(w.y)}; b = (f32x4){bf_lo(w.z), bf_hi(w.z), bf_lo(w.w), bf_hi(w.w)}; }

template <int MODE> struct EpiGen {
    static constexpr bool PERM = true;
    void* O; int ldo; const bf16_t* res; int ldr; const float* bias; float scale;
    __device__ __forceinline__ void piece(size_t row, int col, f32x4 v0, f32x4 v1, const f32x4 b0, const f32x4 b1) const {
        if constexpr (MODE == 0) { v0 = v0 * scale; v1 = v1 * scale; *(u32x4*)((bf16_t*)O + row * ldo + col) = pack8(v0, v1); }
        if constexpr (MODE == 1) { f32x4 r0, r1; unpack8(*(const u32x4*)(res + row * ldr + col), r0, r1); v0 = r0 * ALPHA + v0; v1 = r1 * ALPHA + v1; *(u32x4*)((bf16_t*)O + row * ldo + col) = pack8(v0, v1); }
        if constexpr (MODE == 2) { v0 = v0 + b0; v1 = v1 + b1;
#pragma unroll
            for (int e = 0; e < 4; ++e) { const float a = fmaxf(v0[e], 0.f), b = fmaxf(v1[e], 0.f); v0[e] = a * a; v1[e] = b * b; }
            *(u32x4*)((bf16_t*)O + row * ldo + col) = pack8(v0, v1); }
        if constexpr (MODE == 3) { f32x4 r0, r1; unpack8(*(const u32x4*)(res + row * ldr + col), r0, r1); v0 = r0 * ALPHA + v0 + b0; v1 = r1 * ALPHA + v1 + b1;
            float* o = (float*)O + row * ldo + col; *(f32x4*)o = v0; *(f32x4*)(o + 4) = v1; }
        if constexpr (MODE == 4) { f32x4 r0, r1; unpack8(*(const u32x4*)(res + row * ldr + col), r0, r1); v0 = v0 + b0; v1 = v1 + b1;
#pragma unroll
            for (int e = 0; e < 4; ++e) { v0[e] = r0[e] * sigmoidf_(v0[e]); v1[e] = r1[e] * sigmoidf_(v1[e]); }
            *(u32x4*)((bf16_t*)O + row * ldo + col) = pack8(v0, v1); }
    }
    __device__ __forceinline__ void small(size_t row, int col, const f32x4 v0, const f32x4 v1) const {
        const f32x4 z = (f32x4){0.f, 0.f, 0.f, 0.f};
        piece(row, col, v0, v1, (MODE >= 2) ? *(const f32x4*)(bias + col) : z, (MODE >= 2) ? *(const f32x4*)(bias + col + 4) : z);
    }
    __device__ __forceinline__ void operator()(const f32x4 (&acc)[2][2][4][2], const Unit& u, int wr, int wc, int fr_, int fq_, LAS unsigned char*) const {
        int fr = fr_, fq = fq_; asm volatile("" : "+v"(fr), "+v"(fq));
        const int colb = u.col0 + wc * 32 + 8 * fq;
        f32x4 bv[2][2];
#pragma unroll
        for (int bj = 0; bj < 2; ++bj)
#pragma unroll
            for (int n = 0; n < 2; ++n) bv[bj][n] = (MODE >= 2) ? *(const f32x4*)(bias + colb + bj * HALF + 4 * n) : (f32x4){0.f, 0.f, 0.f, 0.f};
#pragma unroll
        EPI_FOR_ROWS {
            const int rl = ai * HALF + wr * 64 + m * 16 + fr; const size_t row = (size_t)u.row0 + rl;
            if (MODE == 0 && !(u.nvalid >= 0 ? rl < u.nvalid : rl >= 256 + u.nvalid)) continue;
#pragma unroll
            for (int bj = 0; bj < 2; ++bj) piece(row, colb + bj * HALF, acc[ai][bj][m][0], acc[ai][bj][m][1], bv[bj][0], bv[bj][1]);
        }
    }
};

template <int MODE> struct EpiLn {
    static constexpr bool PERM = true, CONS = (MODE != 1), PROD = (MODE == 1 || MODE == 3), RECOMP = (MODE == 3 || MODE == 5);
    void* O; int ldo; const bf16_t* Tin; const f32x2* st_in; f32x2* st_out; const float* va; const float* vb; const float* bias; float scale; int tag0;
    __device__ __forceinline__ void piece(size_t row, int col, f32x4 v0, f32x4 v1, const f32x4 a0, const f32x4 a1, const f32x4 b0, const f32x4 b1, const f32x4 c0, const f32x4 c1,
                                          float mean, float rstd, float& s, float& ss) const {
        if constexpr (MODE == 1) { f32x4 r0, r1; unpack8(*(const u32x4*)(Tin + row * DM + col), r0, r1); v0 = r0 * ALPHA + v0; v1 = r1 * ALPHA + v1; }
        if constexpr (MODE == 2) { v0 = ((v0 - a0 * mean) * rstd + b0) * scale; v1 = ((v1 - a1 * mean) * rstd + b1) * scale; }
        if constexpr (RECOMP) { f32x4 r0, r1; unpack8(*(const u32x4*)(Tin + row * DM + col), r0, r1);
            r0 = (r0 - mean) * rstd * a0 + b0; r1 = (r1 - mean) * rstd * a1 + b1; v0 = r0 * ALPHA + v0; v1 = r1 * ALPHA + v1;
            if constexpr (MODE == 5) { v0 = v0 + c0; v1 = v1 + c1; } }
        if constexpr (MODE == 4) { v0 = (v0 - a0 * mean) * rstd + b0; v1 = (v1 - a1 * mean) * rstd + b1;
#pragma unroll
            for (int e = 0; e < 4; ++e) { const float x = fmaxf(v0[e], 0.f), y = fmaxf(v1[e], 0.f); v0[e] = x * x; v1[e] = y * y; } }
        if constexpr (PROD) {
#pragma unroll
            for (int e = 0; e < 4; ++e) { s += v0[e] + v1[e]; ss += v0[e] * v0[e] + v1[e] * v1[e]; } }
        if constexpr (MODE == 5) { float* o = (float*)O + row * ldo + col; *(f32x4*)o = v0; *(f32x4*)(o + 4) = v1; }
        else *(u32x4*)((bf16_t*)O + row * ldo + col) = pack8(v0, v1);
    }
    __device__ __forceinline__ static void stats_of(const f32x2* st, size_t row, int h, float& s, float& ss) {
        const f32x4* sp = (const f32x4*)(st + row * 16 + h * 8); s = 0.f; ss = 0.f;
#pragma unroll
        for (int q = 0; q < 4; ++q) { const f32x4 v = sp[q]; s += v[0] + v[2]; ss += v[1] + v[3]; }
    }
    __device__ __forceinline__ void small(size_t row, int col, const f32x4 v0, const f32x4 v1) const {
        const f32x4 z = (f32x4){0.f, 0.f, 0.f, 0.f};
        float mean = 0.f, rstd = 0.f;
        if constexpr (CONS) { float s0, q0, s1, q1; stats_of(st_in, row, 0, s0, q0); stats_of(st_in, row, 1, s1, q1); mean = (s0 + s1) * (1.f / DM); rstd = __builtin_amdgcn_rsqf(fmaxf((q0 + q1) * (1.f / DM) - mean * mean, 0.f) + LN_EPS); }
        float s = 0.f, ss = 0.f;
        piece(row, col, v0, v1, CONS ? *(const f32x4*)(va + col) : z, CONS ? *(const f32x4*)(va + col + 4) : z, CONS ? *(const f32x4*)(vb + col) : z, CONS ? *(const f32x4*)(vb + col + 4) : z,
              (MODE == 5) ? *(const f32x4*)(bias + col) : z, (MODE == 5) ? *(const f32x4*)(bias + col + 4) : z, mean, rstd, s, ss);
        if constexpr (PROD) { s += __shfl_xor(s, 1); ss += __shfl_xor(ss, 1); s += __shfl_xor(s, 2); ss += __shfl_xor(ss, 2); s += __shfl_xor(s, 4); ss += __shfl_xor(ss, 4);
            if ((threadIdx.x & 7) == 0) st_out[row * 16 + (col >> 6)] = (f32x2){s, ss}; }
    }
    __device__ __forceinline__ void operator()(const f32x4 (&acc)[2][2][4][2], const Unit& u, int wr, int wc, int fr_, int fq_, LAS unsigned char* ldsx) const {
        int fr = fr_, fq = fq_; asm volatile("" : "+v"(fr), "+v"(fq));
        LAS f32x2* X = (LAS f32x2*)ldsx;
        X += (u.row0 == tag0) ? 0 : 256;
        const int colb = u.col0 + wc * 32 + 8 * fq;
        const f32x4 z = (f32x4){0.f, 0.f, 0.f, 0.f};
        f32x4 av[2][2], bv[2][2], cv[2][2];
#pragma unroll
        for (int bj = 0; bj < 2; ++bj)
#pragma unroll
            for (int n = 0; n < 2; ++n) { av[bj][n] = CONS ? *(const f32x4*)(va + colb + bj * HALF + 4 * n) : z; bv[bj][n] = CONS ? *(const f32x4*)(vb + colb + bj * HALF + 4 * n) : z;
                                          cv[bj][n] = (MODE == 5) ? *(const f32x4*)(bias + colb + bj * HALF + 4 * n) : z; }
#pragma unroll
        EPI_FOR_ROWS {
            const int rl = ai * HALF + wr * 64 + m * 16 + fr; const size_t row = (size_t)u.row0 + rl;
            float mean = 0.f, rstd = 0.f; if constexpr (CONS) { const f32x2 st = X[rl]; mean = st.x; rstd = st.y; }
            float s = 0.f, ss = 0.f;
#pragma unroll
            for (int bj = 0; bj < 2; ++bj) piece(row, colb + bj * HALF, acc[ai][bj][m][0], acc[ai][bj][m][1], av[bj][0], av[bj][1], bv[bj][0], bv[bj][1], cv[bj][0], cv[bj][1], mean, rstd, s, ss);
            if constexpr (PROD) { s += __shfl_xor(s, 16); ss += __shfl_xor(ss, 16); s += __shfl_xor(s, 32); ss += __shfl_xor(ss, 32);
                if (fq == 0) st_out[row * 16 + (u.col0 >> 8) * 4 + wc] = (f32x2){s, ss}; }
        }
    }
    template <class Sched> __device__ __forceinline__ void prep(const Sched& S, LAS unsigned char* ldsx) {
        Unit u; int t0 = 0, t1 = 0; bool any = S.next(0, u);
        if (any) { t0 = u.row0; t1 = t0; for (int i = 1; S.next(i, u); ++i) if (u.row0 != t0) { t1 = u.row0; break; } }
        tag0 = t0;
        if (any) {
            LAS f32x2* X = (LAS f32x2*)ldsx; int t = threadIdx.x; asm volatile("" : "+v"(t));
#pragma unroll
            for (int e = 0; e < 2; ++e) { float s, q; stats_of(st_in, (size_t)(e ? t1 : t0) + (t >> 1), t & 1, s, q);
                s += __shfl_xor(s, 1); q += __shfl_xor(q, 1);
                const float mean = s * (1.f / DM);
                if ((t & 1) == 0) X[e * 256 + (t >> 1)] = (f32x2){mean, __builtin_amdgcn_rsqf(fmaxf(q * (1.f / DM) - mean * mean, 0.f) + LN_EPS)}; }
        }
        __syncthreads();
    }
};
struct EpiWin {
    static constexpr bool PERM = true;
    bf16_t* Ub; bf16_t* Vb; float* out;
    __device__ __forceinline__ void conv_piece(size_t row, int ch, f32x4 v0, f32x4 v1, const f32x4 g0, const f32x4 g1) const {
#pragma unroll
        for (int e = 0; e < 4; ++e) { v0[e] *= sigmoidf_(g0[e]); v1[e] *= sigmoidf_(g1[e]); }
        *(u32x4*)(Vb + row * DCONV + ch) = pack8(v0, v1);
        float* dst = nullptr;
        if (row >= (size_t)NP) { const int r = (int)row - NP; dst = out + O_CVS + (size_t)((r >> 4) * 30 + 14 + (r & 15)) * DCONV + ch; }
        else { const int t = (int)row & (SEQ - 1); if (t >= SEQ - 30) dst = out + O_CVP + (size_t)(((int)row >> 14) * 30 + (t - (SEQ - 30))) * DCONV + ch; }
        if (dst) { *(f32x4*)dst = v0; *(f32x4*)(dst + 4) = v1; }
    }
    __device__ __forceinline__ void small(size_t row, int col, const f32x4 v0, const f32x4 v1) const { *(u32x4*)(Ub + row * DSSM + col) = pack8(v0, v1); }
    __device__ __forceinline__ void operator()(const f32x4 (&acc)[2][2][4][2], const Unit& u, int wr, int wc, int fr_, int fq_, LAS unsigned char*) const {
        int fr = fr_, fq = fq_; asm volatile("" : "+v"(fr), "+v"(fq));
        const int pn = u.aux;
#pragma unroll
        EPI_FOR_ROWS {
            const int rl = ai * HALF + wr * 64 + m * 16 + fr; const size_t row = (size_t)u.row0 + rl;
            if (pn < 2) {
#pragma unroll
                for (int bj = 0; bj < 2; ++bj) *(u32x4*)(Ub + row * DSSM + pn * 256 + bj * HALF + wc * 32 + 8 * fq) = pack8(acc[ai][bj][m][0], acc[ai][bj][m][1]);
            } else {
                conv_piece(row, (pn - 2) * 128 + wc * 32 + 8 * fq, acc[ai][0][m][0], acc[ai][0][m][1], acc[ai][1][m][0], acc[ai][1][m][1]);
            }
        }
    }
};
struct EpiKv {
    static constexpr bool PERM = true;
    bf16_t* Kb; bf16_t* Vt; float* out; int kind; bf16_t* V16;
    __device__ __forceinline__ void small(size_t row, int col, const f32x4 v0, const f32x4 v1) const {
        if (kind == 0) { float* o = out + O_MKP + row * DM + col; *(f32x4*)o = v0; *(f32x4*)(o + 4) = v1; *(u32x4*)(Kb + row * DM + col) = pack8(v0, v1); }
        else if (kind == 1) { float* o = out + O_MVP + row * DM + col; *(f32x4*)o = v0; *(f32x4*)(o + 4) = v1; *(u32x4*)(V16 + row * DM + col) = pack8(v0, v1); }
        else { const int b = col >> 8, key = col & 255; *(u32x4*)(Vt + (size_t)b * (DM * NMEM) + row * NMEM + key) = pack8(v0, v1); }
    }
};
struct EpiSoftmax {
    static constexpr bool PERM = true;
    bf16_t* P;
    __device__ __forceinline__ void operator()(f32x4 (&acc)[2][2][4][2], const Unit& u, int wr, int wc, int fr_, int fq_, LAS unsigned char* ldsx) const {
        int fr = fr_, fq = fq_; asm volatile("" : "+v"(fr), "+v"(fq));
        LAS f32x2* X = (LAS f32x2*)ldsx;
        float mx[2][4];
#pragma unroll
        EPI_FOR_ROWS {
            float mv = -3.0e38f;
#pragma unroll
            for (int bj = 0; bj < 2; ++bj)
#pragma unroll
                for (int n = 0; n < 2; ++n)
#pragma unroll
                    for (int e = 0; e < 4; ++e) mv = fmaxf(mv, acc[ai][bj][m][n][e]);
            mv = fmaxf(mv, __shfl_xor(mv, 16)); mv = fmaxf(mv, __shfl_xor(mv, 32));
            float s = 0.f;
#pragma unroll
            for (int bj = 0; bj < 2; ++bj)
#pragma unroll
                for (int n = 0; n < 2; ++n)
#pragma unroll
                    for (int e = 0; e < 4; ++e) { const float pe = __expf(acc[ai][bj][m][n][e] - mv); acc[ai][bj][m][n][e] = pe; s += pe; }
            s += __shfl_xor(s, 16); s += __shfl_xor(s, 32);
            mx[ai][m] = mv;
            if (fq == 0) X[(ai * HALF + wr * 64 + m * 16 + fr) * 4 + wc] = (f32x2){mv, s};
        }
        asm volatile("s_waitcnt lgkmcnt(0)" ::: "memory"); __builtin_amdgcn_s_barrier(); asm volatile("" ::: "memory");
#pragma unroll
        EPI_FOR_ROWS {
            const int rl = ai * HALF + wr * 64 + m * 16 + fr;
            const f32x2 a = X[rl * 4 + 0], b = X[rl * 4 + 1], c = X[rl * 4 + 2], d = X[rl * 4 + 3];
            const float M = fmaxf(fmaxf(a.x, b.x), fmaxf(c.x, d.x));
            const float Lsum = a.y * __expf(a.x - M) + b.y * __expf(b.x - M) + c.y * __expf(c.x - M) + d.y * __expf(d.x - M);
            const float sc = __expf(mx[ai][m] - M) * __builtin_amdgcn_rcpf(Lsum);
            if (u.nvalid >= 0 ? rl < u.nvalid : rl >= 256 + u.nvalid) {
                const size_t row = (size_t)u.row0 + rl;
#pragma unroll
                for (int bj = 0; bj < 2; ++bj) *(u32x4*)(P + row * DM + u.col0 + bj * HALF + wc * 32 + 8 * fq) = pack8(acc[ai][bj][m][0] * sc, acc[ai][bj][m][1] * sc);
            }
            asm volatile("" ::: "memory");
        }
        asm volatile("s_waitcnt lgkmcnt(0)" ::: "memory"); __builtin_amdgcn_s_barrier(); asm volatile("" ::: "memory");
    }
};
}

template <class Epi, bool PAIR>
__device__ __forceinline__ void small_gemm(LAS unsigned char* lds, const bf16_t* A, int lda, const bf16_t* B, int ldb, int K, int nrg, int nct, size_t row_base, int col_base, const Epi& E, int G, int c) {
    int tid = threadIdx.x; asm volatile("" : "+v"(tid));
    const int wid = __builtin_amdgcn_readfirstlane(tid >> 6), lane = tid & 63, fr = lane & 15, fq = lane >> 4;
    LAS float* red = (LAS float*)lds;
    const int kw = K >> 3, k0 = wid * kw, nks = kw >> 5;
    for (int unit = c; unit < nrg * nct; unit += G) {
        const int rg = unit % nrg, ct = unit / nrg;
        f32x4 acc[4][4];
#pragma unroll
        for (int mi = 0; mi < 4; ++mi)
#pragma unroll
            for (int ni = 0; ni < 4; ++ni) acc[mi][ni] = (f32x4){0.f, 0.f, 0.f, 0.f};
        const bf16_t* ap = A + (size_t)(rg * 64 + fr) * lda + k0 + fq * 8;
        const bf16_t* bp;
        if (PAIR) { const int ch0 = 32 * ct; bp = B + (size_t)(DSSM + 256 * (ch0 >> 7) + (ch0 & 127) + fr) * ldb + k0 + fq * 8; }
        else bp = B + (size_t)(ct * 64 + fr) * ldb + k0 + fq * 8;
#pragma unroll 4
        for (int ks = 0; ks < nks; ++ks) {
            bf16x8 a[4], b[4];
#pragma unroll
            for (int mi = 0; mi < 4; ++mi) a[mi] = *(const bf16x8*)(ap + (size_t)(mi * 16) * lda + ks * 32);
#pragma unroll
            for (int ni = 0; ni < 4; ++ni) { const int roff = PAIR ? ((ni & 1) * 16 + (ni >> 1) * 128) : ni * 16; b[ni] = *(const bf16x8*)(bp + (size_t)roff * ldb + ks * 32); }
#pragma unroll
            for (int mi = 0; mi < 4; ++mi)
#pragma unroll
                for (int ni = 0; ni < 4; ++ni) acc[mi][ni] = __builtin_amdgcn_mfma_f32_16x16x32_bf16(b[ni], a[mi], acc[mi][ni], 0, 0, 0);
        }
        __syncthreads();
#pragma unroll
        for (int mi = 0; mi < 4; ++mi)
#pragma unroll
            for (int ni = 0; ni < 4; ++ni) *(LAS f32x4*)(red + (wid * 64 + mi * 16 + fr) * 68 + ni * 16 + 4 * fq) = acc[mi][ni];
        __syncthreads();
        if constexpr (!PAIR) {
            const int r = tid >> 3, pc = tid & 7; f32x4 v0 = (f32x4){0.f, 0.f, 0.f, 0.f}, v1 = v0;
#pragma unroll
            for (int w = 0; w < 8; ++w) { v0 += *(const LAS f32x4*)(red + (w * 64 + r) * 68 + pc * 8); v1 += *(const LAS f32x4*)(red + (w * 64 + r) * 68 + pc * 8 + 4); }
            E.small(row_base + rg * 64 + r, col_base + ct * 64 + pc * 8, v0, v1);
        } else { if (tid < 256) {
            const int r = tid >> 2, pc = tid & 3; f32x4 v0 = (f32x4){0.f, 0.f, 0.f, 0.f}, v1 = v0, g0 = v0, g1 = v0;
#pragma unroll
            for (int w = 0; w < 8; ++w) { const LAS float* q = red + (w * 64 + r) * 68 + pc * 8;
                v0 += *(const LAS f32x4*)q; v1 += *(const LAS f32x4*)(q + 4); g0 += *(const LAS f32x4*)(q + 32); g1 += *(const LAS f32x4*)(q + 36); }
            E.conv_piece(row_base + rg * 64 + r, 32 * ct + pc * 8, v0, v1, g0, g1);
        } }
    }
    __syncthreads();
}

struct Frame {
    LAS unsigned char* lds; int tid, lane, wave, G, vcu;
};
__device__ __forceinline__ Frame fresh(const Frame& F0) { Frame F = F0; int t = threadIdx.x; asm volatile("" : "+v"(t)); F.tid = t; F.lane = t & 63; F.wave = __builtin_amdgcn_readfirstlane(t >> 6); return F; }

__device__ __forceinline__ void transpose_item(const float* W, int K, int N, bf16_t* WT, int ldt, int k0, int n0, int drow0, LAS float* scr, int lane,
                                               const float* gam = nullptr, const float* bet = nullptr, float* csp = nullptr, float* bcp = nullptr) {
    float tv[32];
#pragma unroll
    for (int i = 0; i < 32; ++i) tv[i] = __builtin_nontemporal_load(W + (size_t)(k0 + 2 * i + (lane >> 5)) * N + n0 + (lane & 31));
#pragma unroll
    for (int i = 0; i < 32; ++i) scr[(2 * i + (lane >> 5)) * 33 + (lane & 31)] = tv[i];
    asm volatile("s_waitcnt lgkmcnt(0)" ::: "memory");
    const int c = lane & 7;
    float ge[8], be[8];
#pragma unroll
    for (int e = 0; e < 8; ++e) { ge[e] = gam ? gam[k0 + 8 * c + e] : 1.f; be[e] = gam ? bet[k0 + 8 * c + e] : 0.f; }
#pragma unroll
    for (int j = 0; j < 4; ++j) { const int n = (lane >> 3) + 8 * j; const LAS float* sp = scr + (8 * c) * 33 + n;
        float w[8];
#pragma unroll
        for (int e = 0; e < 8; ++e) w[e] = sp[e * 33];
        u32x4 o; o.x = cvt_pk_bf16(w[0] * ge[0], w[1] * ge[1]); o.y = cvt_pk_bf16(w[2] * ge[2], w[3] * ge[3]); o.z = cvt_pk_bf16(w[4] * ge[4], w[5] * ge[5]); o.w = cvt_pk_bf16(w[6] * ge[6], w[7] * ge[7]);
        *(u32x4*)(WT + (size_t)(drow0 + n) * ldt + k0 + 8 * c) = o;
        if (gam) {
            float cs = (bf_lo(o.x) + bf_hi(o.x)) + (bf_lo(o.y) + bf_hi(o.y)) + (bf_lo(o.z) + bf_hi(o.z)) + (bf_lo(o.w) + bf_hi(o.w)), bc = 0.f;
#pragma unroll
            for (int e = 0; e < 8; ++e) bc += w[e] * be[e];
            cs += __shfl_xor(cs, 1); cs += __shfl_xor(cs, 2); cs += __shfl_xor(cs, 4); bc += __shfl_xor(bc, 1); bc += __shfl_xor(bc, 2); bc += __shfl_xor(bc, 4);
            if (c == 0) { csp[(size_t)(k0 >> 6) * N + n0 + n] = cs; bcp[(size_t)(k0 >> 6) * N + n0 + n] = bc; }
        }
    }
    asm volatile("s_waitcnt lgkmcnt(0)" ::: "memory");
}
__device__ __forceinline__ int win_dest_row(int n0) {
    if (n0 < DSSM) return n0;
    const int cc = n0 - DSSM;
    if (cc < DCONV) return DSSM + 256 * (cc >> 7) + (cc & 127);
    const int c2 = cc - DCONV; return DSSM + 256 * (c2 >> 7) + 128 + (c2 & 127);
}

__device__ __forceinline__ void ssm_tables(const Params& p, int g, int part, LAS float* sm, int tid) {
    LAS float* pwr = sm;
    LAS float* pwi = sm + 576;
    LAS float* cfr = sm + 1152;
    LAS float* cfi = sm + 1216;
    LAS float* bbr = sm + 1280;
    LAS float* bbi = sm + 2304;
    LAS float* cre = sm + 3328;
    LAS float* cim = sm + 4352;
    LAS float* kc = sm + 5376;
    const float* a_re = p.in[9] + g * 64; const float* a_im = p.in[10] + g * 64; const float* b_re = p.in[12] + (size_t)g * 1024; const float* b_im = p.in[13] + (size_t)g * 1024;
    const float* c_re = p.in[14] + (size_t)g * 1024; const float* c_im = p.in[15] + (size_t)g * 1024;
    const int fa = 12 * part, fb = fa + 12;
    __syncthreads();
    if (tid < 64) {
        const float are = a_re[tid], aim = a_im[tid], dt = expf(p.in[11][g]);
        const float mag = expf(are * dt), ang = aim * dt;
        float sn, cs; sincosf(ang, &sn, &cs);
        const float abr = mag * cs, abi = mag * sn, den = are * are + aim * aim, pp = abr - 1.f, q = abi;
        cfr[tid] = (pp * are + q * aim) / den; cfi[tid] = (q * are - pp * aim) / den;
        float xr = 1.f, xi = 0.f;
#pragma unroll
        for (int k = 0; k < 9; ++k) { pwr[k * 64 + tid] = xr; pwi[k * 64 + tid] = xi; const float nr = xr * abr - xi * abi, ni = xr * abi + xi * abr; xr = nr; xi = ni; }
        if (part == 0) ((f32x2*)(p.ws + WS_M1))[g * 64 + tid] = (f32x2){pwr[8 * 64 + tid], pwi[8 * 64 + tid]};
    }
    for (int e = tid; e < 1024; e += 512) { cre[e] = c_re[e]; cim[e] = c_im[e]; }
    __syncthreads();
    for (int e = tid; e < 1024; e += 512) { const int n = e >> 4; const float br = b_re[e], bi = b_im[e]; bbr[e] = cfr[n] * br - cfi[n] * bi; bbi[e] = cfr[n] * bi + cfi[n] * br; }
    __syncthreads();
    if (fa < 64 && fb > 32) {
        for (int e = tid; e < 2048; e += 512) { const int l = e >> 8, pch = (e >> 4) & 15, q = e & 15; float s = 0.f;
            for (int n = 0; n < 64; ++n) { const float cr = cre[pch * 64 + n], ci = cim[pch * 64 + n], ar = pwr[l * 64 + n], ai = pwi[l * 64 + n];
                const float zr = cr * ar - ci * ai, zi = cr * ai + ci * ar; s += zr * bbr[n * 16 + q] - zi * bbi[n * 16 + q]; }
            kc[e] = s; }
    }
    __syncthreads();
    bf16_t* dst = (bf16_t*)(p.ws + WS_SSMW) + (size_t)g * SSM_FRAG_ELEMS;
    for (int e = fa * 512 + tid; e < fb * 512; e += 512) {
        const int f = e >> 9, l = (e >> 3) & 63, ee = e & 7, lo = l & 15, gq = l >> 4; float v;
        if (f < 32) { const int i = f >> 2, ks = f & 3, np = 16 * i + lo, k = 32 * ks + 8 * gq + ee, sI = k >> 4, q = k & 15, n = np & 63;
            const float ar = pwr[(7 - sI) * 64 + n], ai = pwi[(7 - sI) * 64 + n], br = bbr[n * 16 + q], bi = bbi[n * 16 + q];
            v = (np < 64) ? (ar * br - ai * bi) : (ar * bi + ai * br); }
        else if (f < 64) { const int t = (f - 32) >> 2, ks = (f - 32) & 3, k = 32 * ks + 8 * gq + ee, sI = k >> 4, q = k & 15;
            v = (sI <= t) ? kc[(t - sI) * 256 + lo * 16 + q] : 0.f; }
        else { const int t = (f - 64) >> 2, kap = (f - 64) & 3, tile = (ee < 4) ? 2 * kap : 2 * kap + 1, np = 16 * tile + 4 * gq + (ee & 3), n = np & 63;
            const float cr = cre[lo * 64 + n], ci = cim[lo * 64 + n], ar = pwr[(t + 1) * 64 + n], ai = pwi[(t + 1) * 64 + n];
            v = (np < 64) ? (cr * ar - ci * ai) : -(cr * ai + ci * ar); }
        dst[e] = f2bf(v);
    }
}

__device__ __forceinline__ void p0_prologue(const Params& p, const Frame& F0) {
    const Frame F = fresh(F0);
    LAS float* scr = (LAS float*)(F.lds + F.wave * 16384);
    const int gw = F.vcu * 8 + F.wave, NGW = F.G * 8;
    bf16_t* Win_t = (bf16_t*)(p.ws + WS_WIN); bf16_t* Glu_t = (bf16_t*)(p.ws + WS_GLU); bf16_t* Wout_t = (bf16_t*)(p.ws + WS_WOUT); bf16_t* Wq_t = (bf16_t*)(p.ws + WS_WQ);
    bf16_t* Wkv_t = (bf16_t*)(p.ws + WS_WKV); bf16_t* Wo_t = (bf16_t*)(p.ws + WS_WO); bf16_t* W1_t = (bf16_t*)(p.ws + WS_W1); bf16_t* W2_t = (bf16_t*)(p.ws + WS_W2);
    bf16_t* Vt = (bf16_t*)(p.ws + WS_VT);
    constexpr int I_IN = 16 * 48, I_GLU = 8 * 16, I_SQ = 16 * 32, I_1 = 16 * 128, I_2 = 64 * 32, I_VT = 16 * 4 * 32;
    constexpr int NITEMS = I_IN + I_GLU + 5 * I_SQ + I_1 + I_2 + I_VT;
    for (int it = gw; it < NITEMS; it += NGW) {
        int r = it;
        if (r < I_IN) { const int kb = r / 48, nb = r % 48; transpose_item(p.in[8], DM, DIN, Win_t, DM, 64 * kb, 32 * nb, win_dest_row(32 * nb), scr, F.lane); continue; } r -= I_IN;
        if (r < I_GLU) { const int kb = r / 16, nb = r % 16; transpose_item(p.in[17], DSSM, DSSM, Glu_t, DSSM, 64 * kb, 32 * nb, 32 * nb, scr, F.lane); continue; } r -= I_GLU;
        if (r < 5 * I_SQ) { const int w = r / I_SQ, q = r % I_SQ, kb = q / 32, nb = q % 32;
            const float* src = w == 0 ? p.in[23] : w == 1 ? p.in[26] : w == 2 ? p.in[27] : w == 3 ? p.in[28] : p.in[29];
            bf16_t* dst = w == 0 ? Wout_t : w == 1 ? Wq_t : w == 2 ? Wkv_t : w == 3 ? Wkv_t + (size_t)DM * DM : Wo_t;
            float* csp = (float*)(p.ws + WS_CSP);
            if (w == 1) transpose_item(src, DM, DM, dst, DM, 64 * kb, 32 * nb, 32 * nb, scr, F.lane, p.in[24], p.in[25], csp, csp + 16 * DM);
            else transpose_item(src, DM, DM, dst, DM, 64 * kb, 32 * nb, 32 * nb, scr, F.lane);
            continue; } r -= 5 * I_SQ;
        if (r < I_1) { const int kb = r / 128, nb = r % 128; float* csp = (float*)(p.ws + WS_CSP) + 32 * DM; transpose_item(p.in[32], DM, DFF, W1_t, DM, 64 * kb, 32 * nb, 32 * nb, scr, F.lane, p.in[30], p.in[31], csp, csp + 16 * DFF); continue; } r -= I_1;
        if (r < I_2) { const int kb = r / 32, nb = r % 32; transpose_item(p.in[34], DFF, DM, W2_t, DFF, 64 * kb, 32 * nb, 32 * nb, scr, F.lane); continue; } r -= I_2;
        { const int js = r / 128, q = r % 128, kb = q / 32, nb = q % 32;
          transpose_item(p.in[6] + (size_t)js * NMEM * DM, NMEM, DM, Vt + (size_t)(2 + js) * DM * NMEM, NMEM, 64 * kb, 32 * nb, 32 * nb, scr, F.lane); }
    }
    {
        const size_t gt = (size_t)F.vcu * 512 + F.tid, NT = (size_t)F.G * 512;
        bf16_t* Xb = (bf16_t*)(p.ws + WS_XB); bf16_t* Kb = (bf16_t*)(p.ws + WS_KB); bf16_t* Mb = (bf16_t*)(p.ws + WS_MEMB);
        constexpr size_t C_X = (size_t)R * DM / 8, C_XP = (size_t)NP * DM / 8, C_K = (size_t)NSB * NMEM * DM / 8, C_M = (size_t)NB * NMEM * DM / 8;
        constexpr size_t C_ALL = C_X + C_K + C_M;
        for (size_t i0 = gt; i0 < C_ALL; i0 += 4 * NT) {
            f32x4 a[4], b[4]; bf16_t* dst[4]; bool ok[4];
#pragma unroll
            for (int q = 0; q < 4; ++q) {
                const size_t i = i0 + q * NT; ok[q] = i < C_ALL; const size_t ic = ok[q] ? i : gt; const float* src;
                if (ic < C_X) { src = (ic < C_XP) ? p.in[0] + ic * 8 : p.in[1] + (ic - C_XP) * 8; dst[q] = Xb + ic * 8; }
                else if (ic < C_X + C_K) { const size_t k = ic - C_X; src = p.in[5] + k * 8; dst[q] = Kb + (size_t)NB * NMEM * DM + k * 8; }
                else { const size_t k = ic - C_X - C_K; src = p.in[7] + k * 8; dst[q] = Mb + k * 8; }
                a[q] = __builtin_nontemporal_load((const f32x4*)src); b[q] = __builtin_nontemporal_load((const f32x4*)(src + 4));
            }
#pragma unroll
            for (int q = 0; q < 4; ++q) if (ok[q]) *(u32x4*)dst[q] = pg8::pack8(a[q], b[q]);
        }
        for (size_t i = gt; i < (size_t)NSB * 14 * DCONV / 4; i += NT) { const size_t e = i * 4, js = e / (14 * DCONV), rem = e % (14 * DCONV);
            *(f32x4*)(p.out + O_CVS + js * 30 * DCONV + rem) = *(const f32x4*)(p.in[4] + js * 30 * DCONV + 16 * DCONV + rem); }
    }
    for (int w = blockIdx.x; w < NG * 8; w += F.G) ssm_tables(p, w & (NG - 1), w >> 5, (LAS float*)F.lds, F.tid);
    __syncthreads();
}

template <bool PASS2>
__device__ __forceinline__ void ssm_phase(const Params& p, const Frame& F0) {
    const Frame F = fresh(F0);
    const bf16_t* Ub = (const bf16_t*)(p.ws + WS_UB); bf16_t* Zb = (bf16_t*)(p.ws + WS_ZB);
    float* Wst = (float*)(p.ws + WS_WST);
    const int lane = F.lane, j = lane & 15, gq = lane >> 4;
    for (int pr = blockIdx.x; pr < 256; pr += F.G) {
        const int g = 4 * (pr & 7) + ((pr >> 3) & 3), subset = pr >> 5;
        __syncthreads();
        { const u32x4* src = (const u32x4*)((const bf16_t*)(p.ws + WS_SSMW) + (size_t)g * SSM_FRAG_ELEMS);
          for (int e = F.tid; e < SSM_FRAG_ELEMS / 8; e += 512) ((LAS u32x4*)F.lds)[e] = src[e];
          if (F.tid < 64) ((LAS f32x2*)(F.lds + SSM_M1_OFF))[F.tid] = ((const f32x2*)(p.ws + WS_M1))[g * 64 + F.tid]; }
        __syncthreads();
        const LAS bf16x8* frag = (const LAS bf16x8*)F.lds + lane;
        const LAS f32x4* m1t = (const LAS f32x4*)(F.lds + SSM_M1_OFF) + 2 * gq;
        const int b = subset >> 2, wch = (subset & 3) * 8 + F.wave;
        f32x4 xs[8];
#pragma unroll
        for (int i = 0; i < 8; ++i) xs[i] = (f32x4){0.f, 0.f, 0.f, 0.f};
        if (PASS2 && wch > 0) {
            const float* wb = Wst + (size_t)((g * 2 + b) * 32) * 128;
#pragma unroll
            for (int i = 0; i < 4; ++i) {
                __builtin_amdgcn_sched_barrier(0);
                const f32x4 ma = m1t[8 * i], mb = m1t[8 * i + 1];
                float pr_[4] = {ma[0], ma[2], mb[0], mb[2]}, pi_[4] = {ma[1], ma[3], mb[1], mb[3]};
#pragma unroll
                for (int r = 0; r < 4; ++r) {
#pragma unroll
                    for (int s2 = 0; s2 < 6; ++s2) { const float nr = pr_[r] * pr_[r] - pi_[r] * pi_[r], ni = 2.f * pr_[r] * pi_[r]; pr_[r] = nr; pi_[r] = ni; } }
                f32x4 wre[2], wim[2]; int ex[2];
#pragma unroll
                for (int e = 0; e < 2; ++e) { const int w = j + 16 * e; const bool ok = w < wch; ex[e] = ok ? (wch - 1 - w) : 0; const int wc_ = ok ? w : 0;
                    const f32x4 lr = *(const f32x4*)(wb + wc_ * 128 + 16 * i + 4 * gq), li = *(const f32x4*)(wb + wc_ * 128 + 64 + 16 * i + 4 * gq);
                    wre[e] = ok ? lr : (f32x4){0.f, 0.f, 0.f, 0.f}; wim[e] = ok ? li : (f32x4){0.f, 0.f, 0.f, 0.f}; }
                float fr_[2][4], fi_[2][4];
#pragma unroll
                for (int e = 0; e < 2; ++e)
#pragma unroll
                    for (int r = 0; r < 4; ++r) { fr_[e][r] = 1.f; fi_[e][r] = 0.f; }
#pragma unroll
                for (int bit = 0; bit < 5; ++bit) {
#pragma unroll
                    for (int e = 0; e < 2; ++e) { const bool on = (ex[e] >> bit) & 1;
#pragma unroll
                        for (int r = 0; r < 4; ++r) { const float qr = on ? pr_[r] : 1.f, qi = on ? pi_[r] : 0.f;
                            const float nr = fr_[e][r] * qr - fi_[e][r] * qi, ni = fr_[e][r] * qi + fi_[e][r] * qr; fr_[e][r] = nr; fi_[e][r] = ni; } }
                    if (bit < 4) {
#pragma unroll
                        for (int r = 0; r < 4; ++r) { const float nr = pr_[r] * pr_[r] - pi_[r] * pi_[r], ni = 2.f * pr_[r] * pi_[r]; pr_[r] = nr; pi_[r] = ni; } }
                }
                f32x4 hr, hi;
#pragma unroll
                for (int r = 0; r < 4; ++r) { hr[r] = fr_[0][r] * wre[0][r] - fi_[0][r] * wim[0][r] + fr_[1][r] * wre[1][r] - fi_[1][r] * wim[1][r];
                                              hi[r] = fr_[0][r] * wim[0][r] + fi_[0][r] * wre[0][r] + fr_[1][r] * wim[1][r] + fi_[1][r] * wre[1][r]; }
#pragma unroll
                for (int r = 0; r < 4; ++r) { hr[r] += dppf<DPP_SHR(1)>(hr[r]); hi[r] += dppf<DPP_SHR(1)>(hi[r]); hr[r] += dppf<DPP_SHR(2)>(hr[r]); hi[r] += dppf<DPP_SHR(2)>(hi[r]);
                                              hr[r] += dppf<DPP_SHR(4)>(hr[r]); hi[r] += dppf<DPP_SHR(4)>(hi[r]); hr[r] += dppf<DPP_SHR(8)>(hr[r]); hi[r] += dppf<DPP_SHR(8)>(hi[r]); }
                xs[i] = hr; xs[i + 4] = hi;
            }
        }
        const int nch = 4 + ((PASS2 && F.wave < 2) ? 1 : 0);
        const int jsamp = subset * 2 + F.wave;
#define SSM_ROW0(cc_) (((cc_) == 4) ? (NP + jsamp * NST) : (b * SEQ + (wch * 4 + (cc_)) * 128))
#define SSM_NSUB(cc_) (((cc_) == 4) ? 2 : 16)
#define SSM_LOAD_U(dst, dstu, cc_) { const int r0_ = SSM_ROW0(cc_), ns_ = SSM_NSUB(cc_); const bool ok_ = j < ns_; const int jj_ = ok_ ? j : 0; \
            _Pragma("unroll") for (int ks = 0; ks < 4; ++ks) { const int s_ = 2 * ks + (gq >> 1); \
                const bf16x8 v_ = *(const bf16x8*)(Ub + (size_t)(r0_ + 8 * jj_ + s_) * DSSM + g * 16 + 8 * (gq & 1)); dst[ks] = ok_ ? v_ : (bf16x8){0, 0, 0, 0, 0, 0, 0, 0}; } \
            if (PASS2) { _Pragma("unroll") for (int t = 0; t < 8; ++t) dstu[t] = *(const u32x2*)(Ub + (size_t)(r0_ + 8 * jj_ + t) * DSSM + g * 16 + 4 * gq); } }
        bf16x8 uf[4], ufn[4]; u32x2 uw[8], uwn[8];
        SSM_LOAD_U(uf, uw, 0)
        for (int cc = 0; cc < nch; ++cc) {
            asm volatile("" ::: "memory");
            const bool samp = (cc == 4);
            const int row0 = SSM_ROW0(cc), nsub = SSM_NSUB(cc), js = jsamp;
            if (samp) {
#pragma unroll
                for (int i = 0; i < 4; ++i) { xs[i] = *(const f32x4*)(p.in[2] + (size_t)(js * NG + g) * 64 + 16 * i + 4 * gq); xs[i + 4] = *(const f32x4*)(p.in[3] + (size_t)(js * NG + g) * 64 + 16 * i + 4 * gq); } }
            if (cc + 1 < nch) SSM_LOAD_U(ufn, uwn, cc + 1)
            unsigned hw[4][4];
#pragma unroll
            for (int i = 0; i < 4; ++i) {
                __builtin_amdgcn_sched_barrier(0);
                f32x4 Er = (f32x4){0.f, 0.f, 0.f, 0.f}, Ei = Er;
#pragma unroll
                for (int ks = 0; ks < 4; ++ks) { Er = __builtin_amdgcn_mfma_f32_16x16x32_bf16(frag[(i * 4 + ks) * 64], uf[ks], Er, 0, 0, 0);
                                                 Ei = __builtin_amdgcn_mfma_f32_16x16x32_bf16(frag[((i + 4) * 4 + ks) * 64], uf[ks], Ei, 0, 0, 0); }
                const f32x4 ma = m1t[8 * i], mb = m1t[8 * i + 1];
                float mr[4] = {ma[0], ma[2], mb[0], mb[2]}, mi[4] = {ma[1], ma[3], mb[1], mb[3]};
                float hr[4], hi[4];
#pragma unroll
                for (int r = 0; r < 4; ++r) { hr[r] = dppf<DPP_ROR(1)>(xs[i][r]); hi[r] = dppf<DPP_ROR(1)>(xs[i + 4][r]);
                    if (j == 0) { Er[r] += mr[r] * hr[r] - mi[r] * hi[r]; Ei[r] += mr[r] * hi[r] + mi[r] * hr[r]; } }
#define SSM_SCAN_STEP(D, SQ) { _Pragma("unroll") for (int r = 0; r < 4; ++r) { \
                    const float sr = dppf<DPP_SHR(D)>(Er[r]), si = dppf<DPP_SHR(D)>(Ei[r]); \
                    Er[r] += mr[r] * sr - mi[r] * si; Ei[r] += mr[r] * si + mi[r] * sr; \
                    if (SQ) { const float nr = mr[r] * mr[r] - mi[r] * mi[r], ni = 2.f * mr[r] * mi[r]; mr[r] = nr; mi[r] = ni; } } }
                SSM_SCAN_STEP(1, 1) SSM_SCAN_STEP(2, 1) SSM_SCAN_STEP(4, 1) SSM_SCAN_STEP(8, 0)
#undef SSM_SCAN_STEP
                if constexpr (PASS2) {
                    float vr[4], vi[4];
#pragma unroll
                    for (int r = 0; r < 4; ++r) { const float pr_ = dppf<DPP_ROR(1)>(Er[r]), pi_ = dppf<DPP_ROR(1)>(Ei[r]); vr[r] = (j == 0) ? hr[r] : pr_; vi[r] = (j == 0) ? hi[r] : pi_; }
                    hw[i >> 1][2 * (i & 1)] = cvt_pk_bf16(vr[0], vr[1]); hw[i >> 1][2 * (i & 1) + 1] = cvt_pk_bf16(vr[2], vr[3]);
                    hw[2 + (i >> 1)][2 * (i & 1)] = cvt_pk_bf16(vi[0], vi[1]); hw[2 + (i >> 1)][2 * (i & 1) + 1] = cvt_pk_bf16(vi[2], vi[3]);
                }
                xs[i] = Er; xs[i + 4] = Ei;
            }
            __builtin_amdgcn_sched_barrier(0);
            asm volatile("" ::: "memory");
            if constexpr (PASS2) {
                bf16x8 hf[4];
#pragma unroll
                for (int kap = 0; kap < 4; ++kap) hf[kap] = __builtin_bit_cast(bf16x8, (u32x4){hw[kap][0], hw[kap][1], hw[kap][2], hw[kap][3]});
                const f32x4 dv = *(const f32x4*)(p.in[16] + g * 16 + 4 * gq);
#pragma unroll
                for (int t = 0; t < 8; ++t) {
                    asm volatile("" ::: "memory");
                    f32x4 y = (f32x4){0.f, 0.f, 0.f, 0.f};
#pragma unroll
                    for (int ks = 0; ks < 4; ++ks) y = __builtin_amdgcn_mfma_f32_16x16x32_bf16(frag[(32 + t * 4 + ks) * 64], uf[ks], y, 0, 0, 0);
#pragma unroll
                    for (int kap = 0; kap < 4; ++kap) y = __builtin_amdgcn_mfma_f32_16x16x32_bf16(frag[(64 + t * 4 + kap) * 64], hf[kap], y, 0, 0, 0);
                    if (j < nsub) {
                        const size_t off = (size_t)(row0 + 8 * j + t) * DSSM + g * 16 + 4 * gq;
                        const u32x2 uu = uw[t];
                        const float z0 = gelu_tanh(y[0] + dv[0] * bf_lo(uu.x)), z1 = gelu_tanh(y[1] + dv[1] * bf_hi(uu.x)), z2 = gelu_tanh(y[2] + dv[2] * bf_lo(uu.y)), z3 = gelu_tanh(y[3] + dv[3] * bf_hi(uu.y));
                        *(u32x2*)(Zb + off) = (u32x2){cvt_pk_bf16(z0, z1), cvt_pk_bf16(z2, z3)};
                    }
                }
                if (samp) { if (j == 1) {
#pragma unroll
                        for (int i = 0; i < 4; ++i) { *(f32x4*)(p.out + O_SRS + (size_t)(js * NG + g) * 64 + 16 * i + 4 * gq) = xs[i]; *(f32x4*)(p.out + O_SIS + (size_t)(js * NG + g) * 64 + 16 * i + 4 * gq) = xs[i + 4]; } } }
                else if (cc == 3 && wch == 31 && j == 15) {
#pragma unroll
                    for (int i = 0; i < 4; ++i) { *(f32x4*)(p.out + O_SRP + (size_t)(b * NG + g) * 64 + 16 * i + 4 * gq) = xs[i]; *(f32x4*)(p.out + O_SIP + (size_t)(b * NG + g) * 64 + 16 * i + 4 * gq) = xs[i + 4]; }
                }
            }
#pragma unroll
            for (int ks = 0; ks < 4; ++ks) uf[ks] = ufn[ks];
            if (PASS2) {
#pragma unroll
                for (int t = 0; t < 8; ++t) uw[t] = uwn[t]; }
        }
#undef SSM_ROW0
#undef SSM_NSUB
#undef SSM_LOAD_U
        if constexpr (!PASS2) { if (j == 15) { float* wb = Wst + (size_t)((g * 2 + b) * 32 + wch) * 128;
#pragma unroll
                for (int i = 0; i < 4; ++i) { *(f32x4*)(wb + 16 * i + 4 * gq) = xs[i]; *(f32x4*)(wb + 64 + 16 * i + 4 * gq) = xs[i + 4]; } } }
    }
    __syncthreads();
}

template <int PMODE>
__device__ __forceinline__ void conv_phase(const Params& p, const Frame& F0) {
    const Frame F = fresh(F0);
    const bf16_t* Vb = (const bf16_t*)(p.ws + WS_VB); bf16_t* Cat = (bf16_t*)(p.ws + WS_CAT);
    LAS float* red = (LAS float*)F.lds;
    LAS f32x2* stat = (LAS f32x2*)(F.lds + 64 * 264 * 4);
    const int hb = F.tid >> 8, tt = F.tid & 255, c0 = 2 * tt;
    f32x2 cw[CW];
#pragma unroll
    for (int w = 0; w < CW; ++w) cw[w] = *(const f32x2*)(p.in[19] + w * DCONV + c0);
    const f32x2 cb = *(const f32x2*)(p.in[20] + c0), lg = *(const f32x2*)(p.in[21] + c0), lb = *(const f32x2*)(p.in[22] + c0);
    unsigned wp0[16], wp1[16];
#pragma unroll
    for (int m = 0; m < 16; ++m) { wp0[m] = cvt_pk_bf16(cw[2 * m].x, (2 * m + 1 < CW) ? cw[2 * m + 1 < CW ? 2 * m + 1 : 0].x : 0.f); wp1[m] = cvt_pk_bf16(cw[2 * m].y, (2 * m + 1 < CW) ? cw[2 * m + 1 < CW ? 2 * m + 1 : 0].y : 0.f); }
    unsigned wv[46];
#define CONV_LOAD(unit_) { const int row0_ = (unit_) * 32 + hb * 16; \
        if ((unit_) < NP / 32) { const int t0_ = row0_ & (SEQ - 1); \
            _Pragma("unroll") for (int i = 0; i < 46; ++i) { const bool ok_ = (t0_ - 30 + i) >= 0; const int rr_ = ok_ ? (row0_ - 30 + i) : row0_; \
                const unsigned w_ = *(const unsigned*)(Vb + (size_t)rr_ * DCONV + c0); wv[i] = ok_ ? w_ : 0u; } } \
        else { const int js_ = (row0_ - NP) >> 4; \
            _Pragma("unroll") for (int i = 0; i < 30; ++i) { const f32x2 h_ = *(const f32x2*)(p.in[4] + (size_t)(js_ * 30 + i) * DCONV + c0); wv[i] = cvt_pk_bf16(h_.x, h_.y); } \
            _Pragma("unroll") for (int i = 30; i < 46; ++i) wv[i] = *(const unsigned*)(Vb + (size_t)(row0_ - 30 + i) * DCONV + c0); } }
    if ((int)blockIdx.x < R / 32) CONV_LOAD((int)blockIdx.x)
    for (int unit = blockIdx.x; unit < R / 32; unit += F.G) {
        const int row0 = unit * 32 + hb * 16;
        unsigned P0[46], P1[46];
#pragma unroll
        for (int i = 0; i < 45; ++i) { P0[i] = __builtin_amdgcn_perm(wv[i + 1], wv[i], 0x05040100u); P1[i] = __builtin_amdgcn_perm(wv[i + 1], wv[i], 0x07060302u); }
        P0[45] = wv[45] & 0xffffu; P1[45] = wv[45] >> 16;
        f32x2 acc[16];
#pragma unroll
        for (int k = 0; k < 16; ++k) {
            float a0 = cb.x, a1 = cb.y;
#pragma unroll
            for (int m = 0; m < 16; ++m) {
                a0 = __builtin_amdgcn_fdot2_f32_bf16(__builtin_bit_cast(bf16v2, P0[k + 2 * m]), __builtin_bit_cast(bf16v2, wp0[m]), a0, false);
                a1 = __builtin_amdgcn_fdot2_f32_bf16(__builtin_bit_cast(bf16v2, P1[k + 2 * m]), __builtin_bit_cast(bf16v2, wp1[m]), a1, false);
            }
            acc[k] = (f32x2){a0, a1};
        }
        if (unit + F.G < R / 32) CONV_LOAD(unit + F.G)
        if constexpr (PMODE != 0) { float sk = 0.f;
#pragma unroll
            for (int k = 0; k < 16; ++k) sk += acc[k].x + acc[k].y;
            if (sk == 12345.678f) Cat[0] = 0; continue; }
        LDS_BARRIER();
#pragma unroll
        for (int k = 0; k < 16; ++k) { red[((hb * 32 + k) * 8 + (tt >> 5)) * 33 + (tt & 31)] = acc[k].x + acc[k].y; red[((hb * 32 + 16 + k) * 8 + (tt >> 5)) * 33 + (tt & 31)] = acc[k].x * acc[k].x + acc[k].y * acc[k].y; }
        LDS_BARRIER();
        { const int pair = F.tid >> 3, oct = F.tid & 7; float s = 0.f;
#pragma unroll
          for (int k = 0; k < 32; ++k) s += red[(pair * 8 + oct) * 33 + k];
          s += __shfl_xor(s, 1); s += __shfl_xor(s, 2); s += __shfl_xor(s, 4);
          LDS_BARRIER();
          if (oct == 0) red[pair] = s; }
        LDS_BARRIER();
        if (F.tid < 32) { const int h2 = F.tid >> 4, k = F.tid & 15; const float mean = red[h2 * 32 + k] * (1.f / DCONV), ex2 = red[h2 * 32 + 16 + k] * (1.f / DCONV);
            stat[F.tid] = (f32x2){mean, __builtin_amdgcn_rsqf(fmaxf(ex2 - mean * mean, 0.f) + LN_EPS)}; }
        LDS_BARRIER();
#pragma unroll
        for (int k = 0; k < 16; ++k) { const f32x2 st = stat[hb * 16 + k];
            const float a = (acc[k].x - st.x) * st.y * lg.x + lb.x, b = (acc[k].y - st.x) * st.y * lg.y + lb.y;
            *(unsigned*)(Cat + (size_t)(row0 + k) * DM + DSSM + c0) = cvt_pk_bf16(a * sigmoidf_(a), b * sigmoidf_(b)); }
    }
#undef CONV_LOAD
    __syncthreads();
}


__device__ __forceinline__ void colsum_finalize(const Params& p, const Frame& F0) {
    const Frame F = fresh(F0);
    const float* csp = (const float*)(p.ws + WS_CSP); float* csf = (float*)(p.ws + WS_CSF);
    for (int i = F.vcu * 512 + F.tid; i < 2 * DM + 2 * DFF; i += F.G * 512) {
        const float* src; int N, n; float add = 0.f;
        if (i < DM) { src = csp; N = DM; n = i; } else if (i < 2 * DM) { src = csp + 16 * DM; N = DM; n = i - DM; }
        else if (i < 2 * DM + DFF) { src = csp + 32 * DM; N = DFF; n = i - 2 * DM; } else { src = csp + 32 * DM + 16 * DFF; N = DFF; n = i - 2 * DM - DFF; add = p.in[33][n]; }
        float s = 0.f;
#pragma unroll
        for (int kb = 0; kb < 16; ++kb) s += src[(size_t)kb * N + n];
        csf[i] = s + add;
    }
}

__device__ __forceinline__ void ln_bf16_phase(const Frame& F0, const bf16_t* T, bf16_t* X, const float* gam, const float* bet) {
    const Frame F = fresh(F0);
    const int gw = F.vcu * 8 + F.wave, NGW = F.G * 8;
    f32x4 g4[4], b4[4];
#pragma unroll
    for (int h = 0; h < 2; ++h) { g4[2 * h] = *(const f32x4*)(gam + h * 512 + F.lane * 8); g4[2 * h + 1] = *(const f32x4*)(gam + h * 512 + F.lane * 8 + 4);
        b4[2 * h] = *(const f32x4*)(bet + h * 512 + F.lane * 8); b4[2 * h + 1] = *(const f32x4*)(bet + h * 512 + F.lane * 8 + 4); }
    for (int m = gw; m < R; m += NGW) {
        f32x4 v[4]; float s = 0.f;
#pragma unroll
        for (int h = 0; h < 2; ++h) { pg8::unpack8(*(const u32x4*)(T + (size_t)m * DM + h * 512 + F.lane * 8), v[2 * h], v[2 * h + 1]); }
#pragma unroll
        for (int q = 0; q < 4; ++q) s += (v[q][0] + v[q][1]) + (v[q][2] + v[q][3]);
        const float mean = wave_sum(s) * (1.f / DM); float s2 = 0.f;
#pragma unroll
        for (int q = 0; q < 4; ++q) { v[q] = v[q] - mean; s2 += (v[q][0] * v[q][0] + v[q][1] * v[q][1]) + (v[q][2] * v[q][2] + v[q][3] * v[q][3]); }
        const float rstd = __builtin_amdgcn_rsqf(wave_sum(s2) * (1.f / DM) + LN_EPS);
#pragma unroll
        for (int h = 0; h < 2; ++h) *(u32x4*)(X + (size_t)m * DM + h * 512 + F.lane * 8) = pg8::pack8(v[2 * h] * rstd * g4[2 * h] + b4[2 * h], v[2 * h + 1] * rstd * g4[2 * h + 1] + b4[2 * h + 1]);
    }
}
__device__ __forceinline__ void ln_f32_inplace_phase(const Frame& F0, float* Y, const float* gam, const float* bet) {
    const Frame F = fresh(F0);
    const int gw = F.vcu * 8 + F.wave, NGW = F.G * 8;
    f32x4 g4[4], b4[4];
#pragma unroll
    for (int q = 0; q < 4; ++q) { g4[q] = *(const f32x4*)(gam + q * 256 + F.lane * 4); b4[q] = *(const f32x4*)(bet + q * 256 + F.lane * 4); }
    for (int m0 = gw; m0 < R; m0 += 2 * NGW) {
        const int m1 = m0 + NGW; const bool ok1 = m1 < R; const int mm1 = ok1 ? m1 : m0;
        f32x4 v[2][4];
#pragma unroll
        for (int q = 0; q < 4; ++q) { v[0][q] = *(const f32x4*)(Y + (size_t)m0 * DM + q * 256 + F.lane * 4); v[1][q] = *(const f32x4*)(Y + (size_t)mm1 * DM + q * 256 + F.lane * 4); }
#pragma unroll
        for (int h = 0; h < 2; ++h) {
            float s = 0.f;
#pragma unroll
            for (int q = 0; q < 4; ++q) s += (v[h][q][0] + v[h][q][1]) + (v[h][q][2] + v[h][q][3]);
            const float mean = wave_sum(s) * (1.f / DM); float s2 = 0.f;
#pragma unroll
            for (int q = 0; q < 4; ++q) { v[h][q] = v[h][q] - mean; s2 += (v[h][q][0] * v[h][q][0] + v[h][q][1] * v[h][q][1]) + (v[h][q][2] * v[h][q][2] + v[h][q][3] * v[h][q][3]); }
            const float rstd = __builtin_amdgcn_rsqf(wave_sum(s2) * (1.f / DM) + LN_EPS);
            if (h == 0 || ok1) {
                float* yo = Y + (size_t)(h == 0 ? m0 : m1) * DM;
#pragma unroll
                for (int q = 0; q < 4; ++q) __builtin_nontemporal_store(v[h][q] * rstd * g4[q] + b4[q], (f32x4*)(yo + q * 256 + F.lane * 4));
            }
        }
    }
}

#define XB_TMO      128
#define XB_XCNT(j)  (256  + 64 * (j))
#define XB_XSUB(j)  (1280 + 64 * (j))
#define XB_XGEN(j)  (2304 + 64 * (j))
#define XB_TOP      3328
#define XB_TOPGEN   3392
#define XCD_BAR_WORDS 3456
#define XB_SPIN_CAP (1u << 18)
__device__ __forceinline__ unsigned xb_ld(unsigned* p)              { return __hip_atomic_load(p, __ATOMIC_RELAXED, __HIP_MEMORY_SCOPE_AGENT); }
__device__ __forceinline__ unsigned xb_add(unsigned* p, unsigned v) { return __hip_atomic_fetch_add(p, v, __ATOMIC_RELAXED, __HIP_MEMORY_SCOPE_AGENT); }
__device__ __forceinline__ unsigned xb_xcc_id() { return (unsigned)__builtin_amdgcn_s_getreg((3 << 11) | 20) & 0xFu; }
#define XB_SPIN(cond, bar) do { unsigned _sp = 0; while (cond) { __builtin_amdgcn_s_sleep(1); \
    if ((++_sp & 255u) == 0u) { if (xb_ld(&(bar)[XB_TMO])) break; if (_sp > XB_SPIN_CAP) { atomicAdd(&(bar)[XB_TMO], 1u); break; } } } } while (0)
struct XcdBarrier { unsigned* bar; unsigned x; volatile LAS unsigned* st; };
__device__ __forceinline__ XcdBarrier xcd_barrier_post(unsigned* bar, volatile LAS unsigned* st) {
    XcdBarrier b; b.bar = bar; b.x = xb_xcc_id(); b.st = st;
    if (threadIdx.x == 0) (void)xb_add(&bar[XB_XCNT(b.x)], 1u);
    return b;
}
__device__ __forceinline__ void xcd_barrier_complete(unsigned* bar, unsigned x, unsigned& nloc, unsigned& nx) {
    const unsigned G = gridDim.x * gridDim.y * gridDim.z;
    unsigned sum, cnt, mine, sp = 0u;
    for (;;) {
        sum = 0u; cnt = 0u; mine = 0u;
#pragma unroll
        for (unsigned j = 0; j < 16; ++j) { const unsigned c = xb_ld(&bar[XB_XCNT(j)]); sum += c; cnt += (c > 0u) ? 1u : 0u; mine = (j == x) ? c : mine; }
        if (sum == G) break;
        __builtin_amdgcn_s_sleep(1);
        if ((++sp & 255u) == 0u) { if (xb_ld(&bar[XB_TMO])) break; if (sp > XB_SPIN_CAP) { atomicAdd(&bar[XB_TMO], 1u); break; } }
    }
    nloc = mine > 0u ? mine : 1u; nx = cnt > 0u ? cnt : 1u;
}
__device__ __forceinline__ void xcd_barrier(const XcdBarrier& b) {
    asm volatile("s_waitcnt vmcnt(0)" ::: "memory");
    __syncthreads();
    if (threadIdx.x == 0) {
        unsigned* bar = b.bar;
        __builtin_amdgcn_s_waitcnt(0);
        unsigned nloc = b.st[0], nx = b.st[1];
        if (nloc == 0u) { xcd_barrier_complete(bar, b.x, nloc, nx); b.st[0] = nloc; b.st[1] = nx; }
        const unsigned old = xb_add(&bar[XB_XSUB(b.x)], 1u);
        const unsigned gen = old / nloc;
        if (old + 1u == (gen + 1u) * nloc) {
            __builtin_amdgcn_fence(__ATOMIC_RELEASE, "agent");
            asm volatile("s_waitcnt vmcnt(0)" ::: "memory");
            const unsigned og = xb_add(&bar[XB_TOP], 1u);
            const unsigned tg = og / nx;
            if (og + 1u == (tg + 1u) * nx) xb_add(&bar[XB_TOPGEN], 1u);
            else XB_SPIN(xb_ld(&bar[XB_TOPGEN]) == tg, bar);
            __builtin_amdgcn_fence(__ATOMIC_ACQUIRE, "agent");
            xb_add(&bar[XB_XGEN(b.x)], 1u);
            asm volatile("s_waitcnt vmcnt(0)" ::: "memory");
        } else {
            XB_SPIN(xb_ld(&bar[XB_XGEN(b.x)]) == gen, bar);
            __builtin_amdgcn_fence(__ATOMIC_ACQUIRE, "agent");
            asm volatile("s_waitcnt vmcnt(0)" ::: "memory");
        }
    }
    __syncthreads();
}

__global__ void __launch_bounds__(512, 2) fwd_megakernel(Params p) {
    extern __shared__ __attribute__((aligned(16))) unsigned char lds_raw[];
    cg::grid_group grid = cg::this_grid();
    Frame F; F.lds = (LAS unsigned char*)lds_raw; F.tid = threadIdx.x; F.lane = F.tid & 63; F.wave = __builtin_amdgcn_readfirstlane(F.tid >> 6);
    F.G = gridDim.x; { const int bx = blockIdx.x; F.vcu = (F.G % 8 == 0) ? (bx % 8) * (F.G / 8) + bx / 8 : bx; }
    const int c = blockIdx.x, G = F.G;
    unsigned char* ws = p.ws;
    bf16_t* Xb = (bf16_t*)(ws + WS_XB); bf16_t* Ub = (bf16_t*)(ws + WS_UB); bf16_t* Vb = (bf16_t*)(ws + WS_VB); bf16_t* Zb = (bf16_t*)(ws + WS_ZB); bf16_t* Cat = (bf16_t*)(ws + WS_CAT);
    bf16_t* T1 = (bf16_t*)(ws + WS_T1); f32x2* ST1 = (f32x2*)(ws + WS_ST1); f32x2* ST2 = (f32x2*)(ws + WS_ST2); const float* CSF = (const float*)(ws + WS_CSF); bf16_t* Qb = (bf16_t*)(ws + WS_QB); bf16_t* Pb = (bf16_t*)(ws + WS_PB); bf16_t* Ob = (bf16_t*)(ws + WS_OB);
    bf16_t* T2 = (bf16_t*)(ws + WS_T2); bf16_t* Hb = (bf16_t*)(ws + WS_HB);
    bf16_t* Kb = (bf16_t*)(ws + WS_KB); bf16_t* Vt = (bf16_t*)(ws + WS_VT); bf16_t* Mb = (bf16_t*)(ws + WS_MEMB);
    using namespace pg8;
    { volatile LAS unsigned* st0 = (volatile LAS unsigned*)(F.lds + RING_BYTES + 12288); if (F.tid < 4) st0[F.tid] = 0u; }
    __syncthreads();
    const XcdBarrier xbar = xcd_barrier_post((unsigned*)ws, (volatile LAS unsigned*)(F.lds + RING_BYTES + 12288));
#define GRID_BAR() xcd_barrier(xbar)

    if constexpr (PHASE_MASK & 1) p0_prologue(p, F);
    if constexpr (PROBE_DUP & 1) p0_prologue(p, F);
    if (p.ws == nullptr) grid.sync();
    GRID_BAR();
    for (int rep = 0; rep < ((PROBE_DUP & 2048) ? 2 : 1); ++rep)
    if constexpr (PHASE_MASK & 2) { const bf16_t* Win_t = (const bf16_t*)(ws + WS_WIN); const bf16_t* Wkv_t = (const bf16_t*)(ws + WS_WKV);
      RegSched S; S.init(Xb, DM, Win_t, DM, NP, DIN, G, c); EpiWin E{Ub, Vb, p.out};
      gemm_phase<EpiWin, RegSched, true>(F.lds, GemmDesc{DM, DM, DM}, S, E);
      small_gemm<EpiWin, false>(F.lds, Xb + (size_t)NP * DM, DM, Win_t, DM, DM, 4, 8, NP, 0, E, G, c);
      small_gemm<EpiWin, true>(F.lds, Xb + (size_t)NP * DM, DM, Win_t, DM, DM, 4, 16, NP, 0, E, G, (c + G - 32) % G);
      { EpiKv E2{Kb, Vt, p.out, 0, nullptr}; small_gemm<EpiKv, false>(F.lds, Mb, DM, Wkv_t, DM, DM, 8, 16, 0, 0, E2, G, (c + G - 96) % G); }
      { EpiKv E2{Kb, Vt, p.out, 1, (bf16_t*)(ws + WS_V16)}; small_gemm<EpiKv, false>(F.lds, Mb, DM, Wkv_t + (size_t)DM * DM, DM, DM, 8, 16, 0, 0, E2, G, (c + G - 224) % G); }
        }
    GRID_BAR();
    colsum_finalize(p, F);
    if constexpr (PHASE_MASK & 4) ssm_phase<false>(p, F);
    if constexpr (PHASE_MASK & 8) conv_phase<0>(p, F);
    {
        const bf16_t* Wo_t = (const bf16_t*)(ws + WS_WO); const bf16_t* V16 = (const bf16_t*)(ws + WS_V16); bf16_t* NT = (bf16_t*)(ws + WS_NT);
#pragma unroll 1
        for (int q = 0; q < 8; ++q) { const int b = q >> 2, h = q & 3;
            EpiGen<0> E{NT + (size_t)b * DM * DM, DM, nullptr, 0, nullptr, 1.f};
            small_gemm<EpiGen<0>, false>(F.lds, Wo_t + h * 256, DM, V16 + (size_t)(b * NMEM) * DM + h * 256, DM, HD, 16, 4, 0, h * 256, E, G, (c + G - (64 * q) % G) % G); }
    }
    if constexpr (PROBE_DUP & 2) ssm_phase<false>(p, F);
    if constexpr (PROBE_DUP & 4) conv_phase<0>(p, F);
    if constexpr (PROBE_DUP & 32) conv_phase<1>(p, F);
    if constexpr (PROBE_DUP & 64) conv_phase<2>(p, F);
    GRID_BAR();
    if constexpr (PHASE_MASK & 16) ssm_phase<true>(p, F);
    if constexpr (PROBE_DUP & 8) ssm_phase<true>(p, F);
    GRID_BAR();
    if constexpr (PHASE_MASK & 32) { RegSched S; S.init(Zb, DSSM, (const bf16_t*)(ws + WS_GLU), DSSM, NP, DSSM, G, c); EpiGen<4> E{Cat, DM, Zb, DSSM, p.in[18], 1.f};
      gemm_phase<EpiGen<4>, RegSched, true>(F.lds, GemmDesc{DSSM, DSSM, DSSM}, S, E);
      small_gemm<EpiGen<4>, false>(F.lds, Zb + (size_t)NP * DSSM, DSSM, (const bf16_t*)(ws + WS_GLU), DSSM, DSSM, 4, 8, NP, 0, E, G, c); }
    GRID_BAR();
    if constexpr (PHASE_MASK & 64) { RegSched S; S.init(Cat, DM, (const bf16_t*)(ws + WS_WOUT), DM, NP, DM, G, c); EpiLn<1> E{T1, DM, Xb, nullptr, ST1, nullptr, nullptr, nullptr, 1.f, 0};
      gemm_phase<EpiLn<1>, RegSched, true>(F.lds, GemmDesc{DM, DM, DM}, S, E);
      small_gemm<EpiLn<1>, false>(F.lds, Cat + (size_t)NP * DM, DM, (const bf16_t*)(ws + WS_WOUT), DM, DM, 4, 16, NP, 0, E, G, c); }
    GRID_BAR();
    if constexpr (PHASE_MASK & 256) { RegSched S; S.init(T1, DM, (const bf16_t*)(ws + WS_WQ), DM, NP, DM, G, c); EpiLn<2> E{Qb, DM, nullptr, ST1, nullptr, CSF, CSF + DM, nullptr, 0.0625f, 0}; E.prep(S, F.lds + RING_BYTES);
      gemm_phase<EpiLn<2>, RegSched, true>(F.lds, GemmDesc{DM, DM, DM}, S, E);
      small_gemm<EpiLn<2>, false>(F.lds, T1 + (size_t)NP * DM, DM, (const bf16_t*)(ws + WS_WQ), DM, DM, 4, 16, NP, 0, E, G, c); }
    GRID_BAR();
    for (int rep = 0; rep < ((PROBE_DUP & 1024) ? 2 : 1); ++rep)
    if constexpr (PHASE_MASK & 512) { AttSched S{Qb, Kb, 0, G, c, 0}; EpiSoftmax E{Pb};
      gemm_phase<EpiSoftmax, AttSched, true>(F.lds, GemmDesc{HD, DM, DM}, S, E); }
    asm volatile("s_waitcnt vmcnt(0)" ::: "memory"); __syncthreads();
    if (F.tid == 0) { __builtin_amdgcn_fence(__ATOMIC_ACQUIRE, "agent"); asm volatile("s_waitcnt vmcnt(0)" ::: "memory"); }
    __syncthreads();
    if constexpr (PHASE_MASK & 1024) { AttSched S{Pb, Vt, 1, G, c, 512}; EpiGen<0> E{Ob, DM, nullptr, 0, nullptr, 1.f};
      gemm_phase<EpiGen<0>, AttSched, true>(F.lds, GemmDesc{NMEM, DM, NMEM}, S, E); }
    GRID_BAR();
    if constexpr (PHASE_MASK & 2048) { BatchSched S; S.init(Pb, DM, (const bf16_t*)(ws + WS_NT), DM, NP, DM, G, c); EpiLn<3> E{T2, DM, T1, ST1, ST2, p.in[24], p.in[25], nullptr, 1.f, 0}; E.prep(S, F.lds + RING_BYTES);
      gemm_phase<EpiLn<3>, BatchSched, true>(F.lds, GemmDesc{DM, DM, DM}, S, E);
      small_gemm<EpiLn<3>, false>(F.lds, Ob + (size_t)NP * DM, DM, (const bf16_t*)(ws + WS_WO), DM, DM, 4, 16, NP, 0, E, G, c); }
    GRID_BAR();
    if constexpr (PHASE_MASK & 4096) { RegSched S; S.init(T2, DM, (const bf16_t*)(ws + WS_W1), DM, NP, DFF, G, c); EpiLn<4> E{Hb, DFF, nullptr, ST2, nullptr, CSF + 2 * DM, CSF + 2 * DM + DFF, nullptr, 1.f, 0}; E.prep(S, F.lds + RING_BYTES);
      gemm_phase<EpiLn<4>, RegSched, true>(F.lds, GemmDesc{DM, DM, DM}, S, E);
      small_gemm<EpiLn<4>, false>(F.lds, T2 + (size_t)NP * DM, DM, (const bf16_t*)(ws + WS_W1), DM, DM, 4, 64, NP, 0, E, G, c); }
    GRID_BAR();
    if constexpr (PHASE_MASK & 8192) { RegSched S; S.init(Hb, DFF, (const bf16_t*)(ws + WS_W2), DFF, NP, DM, G, c); EpiLn<5> E{p.out, DM, T2, ST2, nullptr, p.in[30], p.in[31], p.in[35], 1.f, 0}; E.prep(S, F.lds + RING_BYTES);
      gemm_phase<EpiLn<5>, RegSched, true>(F.lds, GemmDesc{DFF, DFF, DFF}, S, E);
      small_gemm<EpiLn<5>, false>(F.lds, Hb + (size_t)NP * DFF, DFF, (const bf16_t*)(ws + WS_W2), DFF, DFF, 4, 16, NP, 0, E, G, c); }
    GRID_BAR();
    if constexpr (PROBE_DUP & 4096) { GRID_BAR(); GRID_BAR(); GRID_BAR(); GRID_BAR(); }
    if constexpr (PHASE_MASK & 16384) ln_f32_inplace_phase(F, p.out, p.in[36], p.in[37]);
}

extern "C" void kernel_launch(void* const* d_in, const int* in_sizes, int n_in, void* d_out, int out_size, void* d_ws, size_t ws_size, hipStream_t stream) {
    static int grid = 0;
    if (grid == 0) {
        if (n_in != 38 || ws_size < WS_END) { fprintf(stderr, "kernel_launch: unexpected n_in %d / ws_size %zu (need %zu)\n", n_in, ws_size, (size_t)WS_END); grid = -1; return; }
        int dev = 0, cus = 0, per_cu = 0;
        hipGetDevice(&dev); hipDeviceGetAttribute(&cus, hipDeviceAttributeMultiprocessorCount, dev);
        hipFuncSetAttribute((const void*)fwd_megakernel, hipFuncAttributeMaxDynamicSharedMemorySize, LDS_BYTES);
        hipOccupancyMaxActiveBlocksPerMultiprocessor(&per_cu, (const void*)fwd_megakernel, 512, LDS_BYTES);
        if (per_cu < 1) { fprintf(stderr, "kernel_launch: occupancy query says %d blocks per CU\n", per_cu); per_cu = 1; }
        grid = cus;
        if (grid > 256) grid = 256;
    }
    if (grid < 0) return;
    Params p{};
    for (int i = 0; i < 38; ++i) p.in[i] = (const float*)d_in[i];
    p.out = (float*)d_out; p.ws = (unsigned char*)d_ws;
    hipMemsetAsync(d_ws, 0, 16384, stream);
    void* args[] = {&p};
    hipError_t e = hipLaunchCooperativeKernel((const void*)fwd_megakernel, dim3(grid), dim3(512), args, LDS_BYTES, stream);
    if (e != hipSuccess) fprintf(stderr, "cooperative launch failed: %s (grid %d)\n", hipGetErrorString(e), grid);
}
```
